# Optimizing an MI355X kernel written in HIP

```python
import math
import jax, jax.numpy as jnp
from jax import lax
import numpy as np

D_MODEL = 1024
BATCH = 2
SEQ = 8192
DEPTH = 4

CTX_LEN = 256
GRID_W = 64
EPS = 1e-6

BR_WIDTH = D_MODEL // 2
N_BRANCH = 3

DA_SUB = 64
DA_VDIM = 2 * DA_SUB
DA_HEADS = BR_WIDTH // DA_VDIM
DA_QK = DA_HEADS * 2 * DA_SUB
BLOCK_Q = 128
ROPE_BASE = 10000.0
ROPE_NF = DA_SUB // 4

HY_WIDTH = BR_WIDTH
HY_SHORT = 3
HY_BANDS = 16
HY_EMB = 1 + 2 * HY_BANDS
HY_HIDDEN = 64
HY_TARGET = 1e-2
HY_FAST_DECAY = 0.3
HY_SLOW_DECAY = 1.5
HY_MIN_DECAY = math.log(HY_TARGET) / HY_SLOW_DECAY
HY_MAX_DECAY = math.log(HY_TARGET) / HY_FAST_DECAY

GM_WIDTH = BR_WIDTH
GM_GROUPS = 8
GM_CHUNK = 128

COL_K = 0
COL_V = COL_K + DA_QK
COL_Q = COL_V + BR_WIDTH
COL_GA = COL_Q + DA_QK
COL_HY = COL_GA + BR_WIDTH
COL_GB = COL_HY + 3 * HY_WIDTH
COL_GM = COL_GB + BR_WIDTH
COL_GC = COL_GM + 2 * GM_WIDTH
COL_MG = COL_GC + BR_WIDTH
COL_END = COL_MG + N_BRANCH * D_MODEL

kernel_name = "hybrid_diffattn_hyena_gmlp_prefix_dit"


def rms_norm(x, g):
    xf = x.astype(jnp.float32)
    y = xf * lax.rsqrt(jnp.mean(xf * xf, axis=-1, keepdims=True) + EPS)
    return (y * g.astype(jnp.float32)).astype(x.dtype)


def layer_norm(x, g, b):
    xf = x.astype(jnp.float32)
    mu = jnp.mean(xf, axis=-1, keepdims=True)
    var = jnp.mean(jnp.square(xf - mu), axis=-1, keepdims=True)
    y = (xf - mu) * lax.rsqrt(var + EPS)
    return (y * g.astype(jnp.float32) + b.astype(jnp.float32)).astype(x.dtype)


def modulation(cond, w, b):
    m = jax.nn.silu(cond) @ w + b
    return jnp.split(m, 3, axis=-1)


def axial_rope(row, col):
    inv = ROPE_BASE ** (-jnp.arange(ROPE_NF, dtype=jnp.float32) / ROPE_NF)
    ang = jnp.stack([row[:, None] * inv, col[:, None] * inv], axis=1)
    return jnp.cos(ang), jnp.sin(ang)


def apply_rope(x, cos, sin):
    xr = x.reshape(*x.shape[:-1], 2, 2, ROPE_NF)
    x1, x2 = xr[..., 0, :], xr[..., 1, :]
    cs, sn = cos.astype(x.dtype), sin.astype(x.dtype)
    out = jnp.stack([x1 * cs - x2 * sn, x2 * cs + x1 * sn], axis=-2)
    return out.reshape(x.shape)


def qk_heads(zs):
    b, n, _ = zs.shape
    return zs.reshape(b, n, DA_HEADS, 2, DA_SUB).transpose(0, 2, 3, 1, 4)


def v_heads(zs):
    b, n, _ = zs.shape
    return zs.reshape(b, n, DA_HEADS, DA_VDIM).transpose(0, 2, 1, 3)


def diff_attend(q, k, v, lam):
    b, h, _, n, _ = q.shape
    nb = n // BLOCK_Q
    qb = q.reshape(b, h, 2, nb, BLOCK_Q, DA_SUB).transpose(3, 0, 1, 2, 4, 5)
    scale = DA_SUB ** -0.5

    def one(qi):
        s = jnp.einsum('bhmqd,bhmkd->bhmqk', qi, k).astype(jnp.float32) * scale
        p = jax.nn.softmax(s, axis=-1)
        w = p[:, :, 0] - lam * p[:, :, 1]
        return jnp.einsum('bhqk,bhkd->bhqd', w.astype(v.dtype), v)

    o = lax.map(one, qb)
    return o.transpose(1, 2, 0, 3, 4).reshape(b, h, n, DA_VDIM)


def diff_head_out(o, g, lam_init):
    o = rms_norm(o, g) * (1.0 - lam_init)
    b, _, n, _ = o.shape
    return o.transpose(0, 2, 1, 3).reshape(b, n, BR_WIDTH)


def hyena_filter(L, w1, b1, w2, b2, w3, freq):
    f32 = jnp.float32
    t = jnp.linspace(0.0, 1.0, L, dtype=f32)[:, None]
    wpos = (2.0 * math.pi / L) * jnp.arange(L, dtype=f32)[:, None]
    bands = jnp.linspace(1e-4, HY_BANDS - 1, HY_BANDS, dtype=f32)[None, :]
    z = jnp.concatenate([t, jnp.cos(bands * wpos), -jnp.sin(bands * wpos)], axis=-1)
    hid = jnp.sin(freq[0].astype(f32) * (z @ w1.astype(f32) + b1.astype(f32)))
    hid = jnp.sin(freq[1].astype(f32) * (hid @ w2.astype(f32) + b2.astype(f32)))
    h = (hid @ w3.astype(f32)).reshape(L, 2, HY_WIDTH)
    deltas = jnp.abs(jnp.linspace(HY_MIN_DECAY, HY_MAX_DECAY, HY_WIDTH, dtype=f32))
    return h * jnp.exp(-t * deltas)[:, None, :]


def long_conv_bidir(u, h, bias):
    L = u.shape[1]
    f32 = jnp.float32
    k = jnp.concatenate([h[:, 0], jnp.zeros((1, HY_WIDTH), f32), h[:0:-1, 1]], axis=0)
    k = k * lax.rsqrt(jnp.sum(k * k, axis=0, keepdims=True))
    kf = jnp.fft.rfft(k, n=2 * L, axis=0)
    uf = jnp.fft.rfft(u.astype(f32), n=2 * L, axis=1)
    y = jnp.fft.irfft(uf * kf[None], n=2 * L, axis=1)[:, :L]
    return (y + u.astype(f32) * bias.astype(f32)).astype(u.dtype)


def short_conv(z, w, b):
    n = z.shape[1]
    pad = HY_SHORT // 2
    zp = jnp.pad(z, ((0, 0), (pad, pad), (0, 0)))
    return sum(zp[:, j:j + n] * w[j] for j in range(HY_SHORT)) + b


def hyena_branch(zb, sw, sb, filt, bias):
    zb = short_conv(zb, sw, sb)
    x0, x1, v = jnp.split(zb, 3, axis=-1)
    return x0 * long_conv_bidir(x1 * v, filt, bias)


def gmlp_branch(zg, ln_g, ln_b, ws, bs):
    u, v = jnp.split(jax.nn.gelu(zg, approximate=False), 2, axis=-1)
    v = layer_norm(v, ln_g, ln_b)
    b, n, _ = v.shape
    vr = v.reshape(b, n // GM_CHUNK, GM_CHUNK, GM_GROUPS, GM_WIDTH // GM_GROUPS)
    vm = jnp.einsum('gpq,bcqgd->bcpgd', ws, vr) + bs.T[:, :, None]
    return u * vm.reshape(b, n, GM_WIDTH)


def merge_branches(z, ys, wb, wo):
    out = None
    for i, (y, g0) in enumerate(zip(ys, (COL_GA, COL_GB, COL_GC))):
        gated = y * jax.nn.silu(z[..., g0:g0 + BR_WIDTH])
        sel = jax.nn.sigmoid(z[..., COL_MG + i * D_MODEL:COL_MG + (i + 1) * D_MODEL])
        term = sel * (gated @ wb[i])
        out = term if out is None else out + term
    return out @ wo


def setup_inputs(seed: int = 0) -> dict:
    key = jax.random.key(seed)
    ks = jax.random.split(key, 26)
    f32 = jnp.float32
    nrm = lambda k, shape, s: jax.random.normal(k, shape, f32) * s
    D = D_MODEL
    return {
        "x": nrm(ks[0], (BATCH, SEQ, D), 1.0),
        "c": nrm(ks[1], (BATCH, D), 1.0),
        "ctx": nrm(ks[2], (BATCH, CTX_LEN, D), 1.0),
        "c_ctx": nrm(ks[3], (D,), 1.0),
        "ada_w": nrm(ks[4], (DEPTH, D, 3 * D), 0.5 * D ** -0.5),
        "ada_b": nrm(ks[5], (DEPTH, 3 * D), 0.01),
        "norm_pre": 1.0 + nrm(ks[6], (DEPTH, D), 0.05),
        "norm_post": 1.0 + nrm(ks[7], (DEPTH, D), 0.05),
        "w_in": nrm(ks[8], (DEPTH, D, COL_END), D ** -0.5),
        "da_lambda": nrm(ks[9], (DEPTH, 4, DA_SUB), 0.1),
        "da_subln": 1.0 + nrm(ks[10], (DEPTH, DA_VDIM), 0.05),
        "hy_short_w": nrm(ks[11], (DEPTH, HY_SHORT, 3 * HY_WIDTH), HY_SHORT ** -0.5),
        "hy_short_b": nrm(ks[12], (DEPTH, 3 * HY_WIDTH), 0.02),
        "hy_f_w1": nrm(ks[13], (DEPTH, HY_EMB, HY_HIDDEN), HY_EMB ** -0.5),
        "hy_f_b1": nrm(ks[14], (DEPTH, HY_HIDDEN), 0.1),
        "hy_f_w2": nrm(ks[15], (DEPTH, HY_HIDDEN, HY_HIDDEN), HY_HIDDEN ** -0.5),
        "hy_f_b2": nrm(ks[16], (DEPTH, HY_HIDDEN), 0.1),
        "hy_f_w3": nrm(ks[17], (DEPTH, HY_HIDDEN, 2 * HY_WIDTH), HY_HIDDEN ** -0.5),
        "hy_f_freq": 1.0 + nrm(ks[18], (DEPTH, 2, HY_HIDDEN), 0.1),
        "hy_bias": nrm(ks[19], (DEPTH, HY_WIDTH), 0.5),
        "gm_ln_g": 1.0 + nrm(ks[20], (DEPTH, GM_WIDTH), 0.05),
        "gm_ln_b": nrm(ks[21], (DEPTH, GM_WIDTH), 0.02),
        "gm_ws": nrm(ks[22], (DEPTH, GM_GROUPS, GM_CHUNK, GM_CHUNK), 0.5 * GM_CHUNK ** -0.5),
        "gm_bs": 1.0 + nrm(ks[23], (DEPTH, GM_GROUPS, GM_CHUNK), 0.1),
        "w_branch": nrm(ks[24], (DEPTH, N_BRANCH, BR_WIDTH, D), BR_WIDTH ** -0.5),
        "w_out": nrm(ks[25], (DEPTH, D, D), D ** -0.5),
    }


def reference(x, c, ctx, c_ctx, ada_w, ada_b, norm_pre, norm_post, w_in, da_lambda, da_subln,
              hy_short_w, hy_short_b, hy_f_w1, hy_f_b1, hy_f_w2, hy_f_b2, hy_f_w3, hy_f_freq, hy_bias,
              gm_ln_g, gm_ln_b, gm_ws, gm_bs, w_branch, w_out):
    n = x.shape[1]
    n_ctx = ctx.shape[1]
    rows = n // GRID_W
    row = jnp.repeat(jnp.arange(rows, dtype=jnp.float32), GRID_W)
    col = jnp.tile(jnp.arange(GRID_W, dtype=jnp.float32), rows)
    cos, sin = axial_rope(row, col)
    xc = ctx
    for l in range(DEPTH):
        last = l == DEPTH - 1
        lam_init = 0.8 - 0.6 * math.exp(-0.3 * l)
        lp = da_lambda[l].astype(jnp.float32)
        lam = jnp.exp(jnp.sum(lp[0] * lp[1])) - jnp.exp(jnp.sum(lp[2] * lp[3])) + lam_init

        sh, sc, gt = modulation(c, ada_w[l], ada_b[l])
        shc, scc, gtc = modulation(c_ctx, ada_w[l], ada_b[l])
        h = rms_norm(x, norm_pre[l]) * (1.0 + sc[:, None]) + sh[:, None]
        hc = rms_norm(xc, norm_pre[l]) * (1.0 + scc) + shc

        z = h @ w_in[l]
        zc = hc @ (w_in[l][:, :COL_Q] if last else w_in[l])
        kc = qk_heads(zc[..., COL_K:COL_V])
        vc = v_heads(zc[..., COL_V:COL_Q])

        q = apply_rope(qk_heads(z[..., COL_Q:COL_GA]), cos, sin)
        k = apply_rope(qk_heads(z[..., COL_K:COL_V]), cos, sin)
        v = v_heads(z[..., COL_V:COL_Q])
        k_all = jnp.concatenate([k, kc], axis=3)
        v_all = jnp.concatenate([v, vc], axis=2)
        y_a = diff_head_out(diff_attend(q, k_all, v_all, lam), da_subln[l], lam_init)
        filt = hyena_filter(n, hy_f_w1[l], hy_f_b1[l], hy_f_w2[l], hy_f_b2[l], hy_f_w3[l], hy_f_freq[l])
        y_b = hyena_branch(z[..., COL_HY:COL_GB], hy_short_w[l], hy_short_b[l], filt, hy_bias[l])
        y_c = gmlp_branch(z[..., COL_GM:COL_GC], gm_ln_g[l], gm_ln_b[l], gm_ws[l], gm_bs[l])
        out = merge_branches(z, (y_a, y_b, y_c), w_branch[l], w_out[l])
        x_new = x + gt[:, None] * rms_norm(out, norm_post[l])

        if not last:
            qc = qk_heads(zc[..., COL_Q:COL_GA])
            yc_a = diff_head_out(diff_attend(qc, kc, vc, lam), da_subln[l], lam_init)
            filt_c = hyena_filter(n_ctx, hy_f_w1[l], hy_f_b1[l], hy_f_w2[l], hy_f_b2[l], hy_f_w3[l], hy_f_freq[l])
            yc_b = hyena_branch(zc[..., COL_HY:COL_GB], hy_short_w[l], hy_short_b[l], filt_c, hy_bias[l])
            yc_c = gmlp_branch(zc[..., COL_GM:COL_GC], gm_ln_g[l], gm_ln_b[l], gm_ws[l], gm_bs[l])
            outc = merge_branches(zc, (yc_a, yc_b, yc_c), w_branch[l], w_out[l])
            xc = xc + gtc * rms_norm(outc, norm_post[l])
        x = x_new
    return x
```

```cpp
#include <hip/hip_runtime.h>
#include <hip/hip_cooperative_groups.h>
#include <cstdio>
#include <cstdint>
#include <cmath>
namespace cg = cooperative_groups;
namespace pg8 {
#define PG8_LAS __attribute__((address_space(3)))
typedef unsigned short bf16_t;
typedef short bf16x8 __attribute__((ext_vector_type(8)));
typedef float f32x4 __attribute__((ext_vector_type(4)));
typedef unsigned u32x4 __attribute__((ext_vector_type(4)));
constexpr int BM = 256, BK = 64, HALF = 128, HTB = HALF * BK * 2  , STAGE_BYTES = 8 * HTB, NXCD = 8, WGM = 8;

__host__ __device__ __forceinline__ int lds_byte(int r, int c) { const int st = (r >> 4) * 2 + (c >> 5), rr = r & 15, cc = c & 31, ob = rr * 64 + cc * 2; return st * 1024 + (ob ^ (((ob >> 9) & 1) << 5)); }
__host__ __device__ __forceinline__ void stage_rc(int b, int& R, int& C) { const int st = b / 1024, sb = b % 1024, swz = sb ^ (((sb >> 9) & 1) << 5); R = (st >> 1) * 16 + swz / 64; C = (st & 1) * 32 + (swz % 64) / 2; }
__host__ __device__ __forceinline__ int perm32(int rho) { const int n = rho >> 4, i = rho & 15; return 8 * (i >> 2) + 4 * n + (i & 3); }

struct Unit { int pm, pn; };
struct Gemm { const bf16_t* A; const bf16_t* Bt; int M, N, K; };

struct StaticOrder {
    int nM, nN, nwg, G, c;
    __host__ __device__ void init(int M, int N, int G_, int c_) { nM = M / BM; nN = N / BM; nwg = nM * nN; G = G_; c = c_; }
    __host__ __device__ bool next(int i, Unit& u) const {
        const long L = (long)i * G + c; if (L >= nwg) return false;
        int wgid = (int)L; { const int q = nwg / NXCD, r = nwg % NXCD, xcd = wgid % NXCD, off = wgid / NXCD; wgid = (xcd < r ? xcd * (q + 1) : r * (q + 1) + (xcd - r) * q) + off; }
        const int nig = WGM * nN, gid = wgid / nig, fm = gid * WGM, gsz = (nM - fm) < WGM ? (nM - fm) : WGM;
        u.pm = fm + ((wgid % nig) % gsz); u.pn = (wgid % nig) / gsz; return true;
    }
    __device__ __forceinline__ void a_ready(const Unit&) const {}
    __device__ __forceinline__ void done(const Unit&) const {}
};

__device__ __forceinline__ unsigned cvt_pk_bf16(float lo, float hi) { unsigned r; asm volatile("v_cvt_pk_bf16_f32 %0, %1, %2" : "=v"(r) : "v"(lo), "v"(hi)); return r; }
typedef float f32x2 __attribute__((ext_vector_type(2)));
__device__ __forceinline__ f32x2 gelu_pk(f32x2 v) {
    const f32x2 av = __builtin_elementwise_abs(v), d = av * 0.2316418882f + 1.0f;
    f32x2 t; t.x = __builtin_amdgcn_rcpf(d.x); t.y = __builtin_amdgcn_rcpf(d.y);
    f32x2 q = t * 0.5307027145f + (-0.7265760135f); q = q * t + 0.7107068705f; q = q * t + (-0.142248368f); q = q * t + 0.127414796f; q = q * t;
    const f32x2 s = (v * v) * (-0.72134752044f);
    f32x2 e; e.x = __builtin_amdgcn_exp2f(s.x); e.y = __builtin_amdgcn_exp2f(s.y);
    const f32x2 m = v * (q * e), r = v - m;
    f32x2 o; o.x = v.x < 0.f ? m.x : r.x; o.y = v.y < 0.f ? m.y : r.y; return o;
}

struct NoHook { static constexpr bool ON = false; template <class A> __device__ __forceinline__ void operator()(A&, const Unit&, int, int, int, int, int) const {} };
template <class Epi, class Sched, bool ALIGN_EPI = false, bool SP2 = false, class Hook = NoHook>
__device__ __forceinline__ void gemm_phase(PG8_LAS unsigned char* lds, const Gemm g, const Sched& S, const Epi& E, int tid, const Hook& H = Hook()) {
    const int wid = __builtin_amdgcn_readfirstlane(tid >> 6), lane = tid & 63, wr = wid >> 2, wc = wid & 3, fr = lane & 15, fq = lane >> 4;
    const int K = g.K, nt = K / BK;
    unsigned voffA[2], voffB[2];
#pragma unroll
    for (int i = 0; i < 2; ++i) { int R, C; stage_rc(tid * 16 + i * 8192, R, C); const int Rb = Epi::PERM ? ((R & ~31) + perm32(R & 31)) : R;
        voffA[i] = (unsigned)(R * K + C) * 2u; voffB[i] = (unsigned)(Rb * K + C) * 2u; }
    const size_t kstep = (size_t)(BK * 2);
    const size_t hstep = (size_t)HALF * K * 2;
    const size_t tstep = 2 * hstep;
    const unsigned ldsw = (unsigned)wid * 1024u;
    const int aoff = lds_byte(wr * 64 + fr, fq * 8), boff = lds_byte(wc * 32 + fr, fq * 8);
#define PG8_SA(b, h) (((b) * 2 + (h)) * HTB)
#define PG8_SB(b, h) ((4 + (b) * 2 + (h)) * HTB)
#define PG8_STAGE(bufoff, gbase, voff) do { _Pragma("unroll") for (int _i = 0; _i < 2; ++_i) \
        __builtin_amdgcn_global_load_lds((const unsigned*)((const char*)(gbase) + (voff)[_i]), (PG8_LAS unsigned*)(lds + (bufoff) + ldsw + _i * 8192), 16, 0, 0); } while (0)
#define PG8_LDA(dst, b, h) do { _Pragma("unroll") for (int m = 0; m < 4; ++m) _Pragma("unroll") for (int k = 0; k < 2; ++k) dst[m][k] = *(const PG8_LAS bf16x8*)(lds + PG8_SA(b, h) + aoff + m * 2048 + k * 1024); } while (0)
#define PG8_LDB(dst, b, h) do { _Pragma("unroll") for (int n = 0; n < 2; ++n) _Pragma("unroll") for (int k = 0; k < 2; ++k) dst[n][k] = *(const PG8_LAS bf16x8*)(lds + PG8_SB(b, h) + boff + n * 2048 + k * 1024); } while (0)
#define PG8_MMA(ai, bj, At, Bt) do { __builtin_amdgcn_s_setprio(1); _Pragma("unroll") for (int m = 0; m < 4; ++m) _Pragma("unroll") for (int n = 0; n < 2; ++n) _Pragma("unroll") for (int k = 0; k < 2; ++k) \
        acc[ai][bj][m][n] = __builtin_amdgcn_mfma_f32_16x16x32_bf16(Bt[n][k], At[m][k], acc[ai][bj][m][n], 0, 0, 0); __builtin_amdgcn_s_setprio(0); } while (0)
#define PG8_WAIT_V(n) asm volatile("s_waitcnt vmcnt(" #n ")" ::: "memory")
#define PG8_WAIT_L(n) asm volatile("s_waitcnt lgkmcnt(" #n ")" ::: "memory")
#define PG8_BAR __builtin_amdgcn_s_barrier()
#define PG8_SCHED __builtin_amdgcn_sched_barrier(0)
    Unit cur, nxt; int ui = 0;
    if (!S.next(0, cur)) return;
    f32x4 acc[2][2][4][2];
#pragma unroll
    for (int a = 0; a < 2; ++a)
#pragma unroll
        for (int b = 0; b < 2; ++b)
#pragma unroll
            for (int m = 0; m < 4; ++m)
#pragma unroll
                for (int n = 0; n < 2; ++n) acc[a][b][m][n] = (f32x4){0.f, 0.f, 0.f, 0.f};
    bf16x8 At[4][2], B0[2][2], B1[2][2];
    const char* cA = (const char*)g.A + (size_t)cur.pm * tstep; const char* cB = (const char*)g.Bt + (size_t)cur.pn * tstep;
    S.a_ready(cur);
    if constexpr (SP2) {
        PG8_STAGE(PG8_SB(0, 0), cB, voffB); PG8_STAGE(PG8_SB(0, 1), cB + hstep, voffB); PG8_STAGE(PG8_SA(0, 0), cA, voffA); PG8_STAGE(PG8_SA(0, 1), cA + hstep, voffA);
        if (wr == 1) PG8_BAR;
        PG8_WAIT_V(2); PG8_BAR;
        PG8_STAGE(PG8_SB(1, 0), cB + kstep, voffB); PG8_STAGE(PG8_SA(1, 0), cA + kstep, voffA); PG8_STAGE(PG8_SB(1, 1), cB + hstep + kstep, voffB);
        PG8_WAIT_V(6); PG8_BAR;
    } else {
        PG8_STAGE(PG8_SB(0, 0), cB, voffB); PG8_STAGE(PG8_SA(0, 0), cA, voffA); PG8_STAGE(PG8_SB(0, 1), cB + hstep, voffB); PG8_STAGE(PG8_SA(0, 1), cA + hstep, voffA);
        if (wr == 1) PG8_BAR;
        PG8_WAIT_V(4); PG8_BAR;
        PG8_STAGE(PG8_SB(1, 0), cB + kstep, voffB); PG8_STAGE(PG8_SA(1, 0), cA + kstep, voffA); PG8_STAGE(PG8_SB(1, 1), cB + hstep + kstep, voffB);
        PG8_WAIT_V(6); PG8_BAR;
    }
    for (;;) {
        const bool has_next = S.next(ui + 1, nxt);
        const char* nA = has_next ? (const char*)g.A + (size_t)nxt.pm * tstep : cA; const char* nB = has_next ? (const char*)g.Bt + (size_t)nxt.pn * tstep : cB;
        for (int t = 0; t < nt; t += 2) {
            if constexpr (Hook::ON) { if (t == 8 || t == 16) H(acc, cur, wr, wc, fr, fq, t); }
            const bool last = (t == nt - 2);
            const char* a1 = cA + (size_t)(t + 1) * kstep;
            const char* a2 = last ? nA : cA + (size_t)(t + 2) * kstep; const char* b2 = last ? nB : cB + (size_t)(t + 2) * kstep;
            const char* a3 = a2 + kstep; const char* b3 = b2 + kstep;
            if (last && has_next) S.a_ready(nxt);
            if constexpr (SP2) {
            PG8_LDB(B0, 0, 0); PG8_LDB(B1, 0, 1); PG8_SCHED; PG8_LDA(At, 0, 0); PG8_STAGE(PG8_SA(1, 1), a1 + hstep, voffA);
            PG8_WAIT_V(8); PG8_WAIT_L(0); PG8_BAR; PG8_MMA(0, 0, At, B0); PG8_MMA(0, 1, At, B1); PG8_BAR; PG8_SCHED;
            PG8_LDA(At, 0, 1); PG8_STAGE(PG8_SB(0, 0), b2, voffB); PG8_STAGE(PG8_SB(0, 1), b2 + hstep, voffB); PG8_STAGE(PG8_SA(0, 0), a2, voffA);
            PG8_WAIT_V(8); PG8_WAIT_L(0); PG8_BAR; PG8_MMA(1, 0, At, B0); PG8_MMA(1, 1, At, B1); PG8_BAR; PG8_SCHED;
            PG8_LDB(B0, 1, 0); PG8_LDB(B1, 1, 1); PG8_SCHED; PG8_LDA(At, 1, 0); PG8_STAGE(PG8_SA(0, 1), a2 + hstep, voffA);
            PG8_WAIT_V(8); PG8_WAIT_L(0); PG8_BAR; PG8_MMA(0, 0, At, B0); PG8_MMA(0, 1, At, B1); PG8_BAR; PG8_SCHED;
            PG8_LDA(At, 1, 1); PG8_STAGE(PG8_SB(1, 0), b3, voffB); PG8_STAGE(PG8_SB(1, 1), b3 + hstep, voffB); PG8_STAGE(PG8_SA(1, 0), a3, voffA);
            PG8_WAIT_V(8); PG8_WAIT_L(0); PG8_BAR; PG8_MMA(1, 0, At, B0); PG8_MMA(1, 1, At, B1); PG8_BAR; PG8_SCHED;
            } else {
            PG8_LDB(B0, 0, 0); PG8_SCHED; PG8_LDA(At, 0, 0); PG8_STAGE(PG8_SA(1, 1), a1 + hstep, voffA);
            PG8_WAIT_L(8); PG8_BAR; PG8_WAIT_L(0); PG8_MMA(0, 0, At, B0); PG8_BAR; PG8_SCHED;
            PG8_LDB(B1, 0, 1); PG8_STAGE(PG8_SB(0, 0), b2, voffB);
            PG8_BAR; PG8_WAIT_L(0); PG8_MMA(0, 1, At, B1); PG8_BAR;
            PG8_LDA(At, 0, 1); PG8_STAGE(PG8_SA(0, 0), a2, voffA);
            PG8_BAR; PG8_WAIT_L(0); PG8_MMA(1, 0, At, B0); PG8_BAR; PG8_SCHED;
            PG8_STAGE(PG8_SB(0, 1), b2 + hstep, voffB);
            PG8_WAIT_V(6); PG8_BAR; PG8_MMA(1, 1, At, B1); PG8_BAR;
            PG8_LDB(B0, 1, 0); PG8_SCHED; PG8_LDA(At, 1, 0); PG8_STAGE(PG8_SA(0, 1), a2 + hstep, voffA);
            PG8_WAIT_L(8); PG8_BAR; PG8_WAIT_L(0); PG8_MMA(0, 0, At, B0); PG8_BAR; PG8_SCHED;
            PG8_LDB(B1, 1, 1); PG8_STAGE(PG8_SB(1, 0), b3, voffB);
            PG8_BAR; PG8_WAIT_L(0); PG8_MMA(0, 1, At, B1); PG8_BAR;
            PG8_LDA(At, 1, 1); PG8_STAGE(PG8_SA(1, 0), a3, voffA);
            PG8_BAR; PG8_WAIT_L(0); PG8_MMA(1, 0, At, B0); PG8_BAR; PG8_SCHED;
            PG8_STAGE(PG8_SB(1, 1), b3 + hstep, voffB);
            PG8_WAIT_V(6); PG8_BAR; PG8_MMA(1, 1, At, B1); PG8_BAR;
            }
        }
        if constexpr (ALIGN_EPI) { if (wr == 0) PG8_BAR; }
        if constexpr (!Epi::AFTER_DRAIN) { E(acc, cur, wr, wc, fr, fq); S.done(cur); }
        if (!has_next) break;
#pragma unroll
        for (int a = 0; a < 2; ++a)
#pragma unroll
            for (int b = 0; b < 2; ++b)
#pragma unroll
                for (int m = 0; m < 4; ++m)
#pragma unroll
                    for (int n = 0; n < 2; ++n) acc[a][b][m][n] = (f32x4){0.f, 0.f, 0.f, 0.f};
        cur = nxt; cA = nA; cB = nB; ++ui;
        if constexpr (ALIGN_EPI) { if (wr == 1) PG8_BAR; }
    }
    PG8_WAIT_V(0);
    if constexpr (!ALIGN_EPI) { if (wr == 0) PG8_BAR; }
    PG8_BAR;
    if constexpr (Epi::AFTER_DRAIN) { E.fused(acc, cur, wr, wc, fr, fq, lds, wid, lane); S.done(cur); }
#undef PG8_SA
#undef PG8_SB
#undef PG8_STAGE
#undef PG8_LDA
#undef PG8_LDB
#undef PG8_MMA
#undef PG8_WAIT_V
#undef PG8_WAIT_L
#undef PG8_BAR
#undef PG8_SCHED
}
}
#ifndef REP_B
#define REP_B 1
#endif
#ifndef REP_ATT
#define REP_ATT 1
#endif
#ifndef REP_HY
#define REP_HY 1
#endif
#ifndef REP_GM
#define REP_GM 1
#endif
#ifndef REP_DE
#define REP_DE 1
#endif
#ifndef REP_A2
#define REP_A2 1
#endif
#ifndef REP_SYNC
#define REP_SYNC 1
#endif
#ifndef MK_ONE_LAUNCH
#define MK_ONE_LAUNCH 1
#endif
#define LAS __attribute__((address_space(3)))
typedef unsigned short bf16;
typedef float f32x4 __attribute__((ext_vector_type(4)));
typedef float f32x2 __attribute__((ext_vector_type(2)));
typedef float f32x16 __attribute__((ext_vector_type(16)));
typedef short bf16x8 __attribute__((ext_vector_type(8)));
typedef unsigned u32x2 __attribute__((ext_vector_type(2)));
typedef unsigned u32x4 __attribute__((ext_vector_type(4)));

constexpr int DM = 1024, SEQ = 8192, CTXL = 256, MROWS = 16896, MLAT = 16384, NCOL = 8704, KEYS = 8448, DEPTH = 4;
constexpr float EPSN = 1e-6f;
constexpr float QSCALE = 0.125f * 1.4426950408889634f;
constexpr size_t MiB = 1u << 20;
constexpr size_t WS_CTL = 0, WS_BAR = 65536, WS_MODP = 1 * MiB, WS_ROPE = 3 * MiB, WS_XC = 4 * MiB, WS_WIN = 8 * MiB, WS_WBR = 25 * MiB, WS_WOUT = 28 * MiB,
    WS_H = 32 * MiB, WS_K = 66 * MiB, WS_Q = 83 * MiB, WS_VT = 100 * MiB, WS_GA = 117 * MiB, WS_GC = 134 * MiB, WS_ZGM = 151 * MiB, WS_SEL = 184 * MiB,
    WS_ZHYT = 283 * MiB, WS_ZHYTC = 331 * MiB, WS_GBT = 333 * MiB, WS_GBTC = 349 * MiB, WS_GATED = 350 * MiB, WS_FILT = 400 * MiB, WS_FILTC = 432 * MiB  , WS_END = 436 * MiB;
constexpr size_t WS_OUTPRE = WS_H, WS_OUT = WS_SEL, WS_TMP = WS_ZHYT;
constexpr size_t GATED_STRIDE = (size_t)MROWS * 512;
constexpr int LDS_BYTES = 147456;
constexpr int NPHASE = 22;

struct Params { const float* in[26]; float* out; unsigned char* ws; int ph_lo, ph_hi; };
enum { I_X = 0, I_C, I_CTX, I_CCTX, I_ADAW, I_ADAB, I_NPRE, I_NPOST, I_WIN, I_LAM, I_SUBLN, I_SW, I_SB, I_FW1, I_FB1, I_FW2, I_FB2, I_FW3, I_FFREQ, I_HBIAS, I_LNG, I_LNB, I_GWS, I_GBS, I_WBR, I_WOUT };

#define MK_TIDS(w0) int tid; asm volatile("v_mbcnt_lo_u32_b32 %0, -1, 0\n\tv_mbcnt_hi_u32_b32 %0, -1, %0" : "=v"(tid)); const int lane = tid; tid += (w0) * 64; const int wid = (w0);
__device__ __forceinline__ int mk_tid(int w0) { int t; asm volatile("v_mbcnt_lo_u32_b32 %0, -1, 0\n\tv_mbcnt_hi_u32_b32 %0, -1, %0" : "=v"(t)); return t + w0 * 64; }
__device__ __forceinline__ float bf2f(unsigned b) { return __uint_as_float(b << 16); }
__device__ __forceinline__ bf16 f2bf(float v) { return (bf16)(pg8::cvt_pk_bf16(v, 0.f) & 0xffffu); }
__device__ __forceinline__ float wave_sum(float v) {
#pragma unroll
    for (int o = 1; o < 64; o <<= 1) v += __shfl_xor(v, o);
    return v;
}
__device__ __forceinline__ float silu_f(float x) { return x * __builtin_amdgcn_rcpf(1.f + __expf(-x)); }
__device__ __forceinline__ float sigm_f(float x) { return __builtin_amdgcn_rcpf(1.f + __expf(-x)); }
__device__ __forceinline__ int crow(int r, int hi) { return (r & 3) + 8 * (r >> 2) + 4 * hi; }

struct EpiIn {
    static constexpr bool PERM = false, AFTER_DRAIN = false;
    bf16 *K, *Q, *Vt, *ga, *gc, *zgm, *sel, *zhyT, *zhyTc, *gbT, *gbTc; const float* rope; unsigned* kmax; int last;
    template <int ACT> __device__ __forceinline__ static float act(float v) { if (ACT == 1) return silu_f(v); if (ACT == 3) return sigm_f(v); return v; }
    template <int ACT> __device__ __forceinline__ void rowmajor(const f32x4 (&acc)[2][2][4][2], bf16* dst, int ld, int colbase, int row0, int wc, int fq) const {
#pragma unroll
        for (int ai = 0; ai < 2; ++ai)
#pragma unroll
            for (int m = 0; m < 4; ++m) { bf16* rowp = dst + (size_t)(row0 + ai * 128 + m * 16) * ld + colbase + wc * 32 + 4 * fq;
#pragma unroll
                for (int bj = 0; bj < 2; ++bj)
#pragma unroll
                    for (int n = 0; n < 2; ++n) { f32x4 v = acc[ai][bj][m][n];
                        if (ACT == 2) { f32x2 a = pg8::gelu_pk((f32x2){v[0], v[1]}), b = pg8::gelu_pk((f32x2){v[2], v[3]}); v = (f32x4){a.x, a.y, b.x, b.y}; }
                        else { v[0] = act<ACT>(v[0]); v[1] = act<ACT>(v[1]); v[2] = act<ACT>(v[2]); v[3] = act<ACT>(v[3]); }
                        u32x2 w; w.x = pg8::cvt_pk_bf16(v[0], v[1]); w.y = pg8::cvt_pk_bf16(v[2], v[3]); *(u32x2*)(rowp + bj * 128 + n * 16) = w; } }
    }
    template <int ACT> __device__ __forceinline__ void transposed(const f32x4 (&acc)[2][2][4][2], bf16* dstT, int LT, int colbase, int t0, int wc, int fq) const {
#pragma unroll
        for (int ai = 0; ai < 2; ++ai)
#pragma unroll
            for (int m = 0; m < 4; ++m) { const int t = t0 + ai * 128 + m * 16;
#pragma unroll
                for (int bj = 0; bj < 2; ++bj)
#pragma unroll
                    for (int n = 0; n < 2; ++n) { const f32x4 v = acc[ai][bj][m][n]; const int col = colbase + bj * 128 + wc * 32 + n * 16 + 4 * fq;
#pragma unroll
                        for (int i = 0; i < 4; ++i) dstT[(size_t)(col + i) * LT + t] = f2bf(act<ACT>(v[i])); } }
    }
    __device__ __forceinline__ void operator()(const f32x4 (&acc)[2][2][4][2], const pg8::Unit& u, int wr, int wc, int fr, int fq) const {
        asm volatile("" : "+v"(fr), "+v"(fq));
        const int pm = u.pm, pn = u.pn;
        const bool isctx = pm >= 64; const int b = isctx ? pm - 64 : (pm >> 5); const int t0 = (isctx ? 0 : (pm & 31) * 256) + wr * 64 + fr;
        const int row0 = pm * 256 + wr * 64 + fr;
        if (isctx && last && pn >= 4) return;
        if (pn < 2 || (pn >= 4 && pn < 6)) {
            const bool isq = pn >= 4; const int hp = isq ? pn - 4 : pn; const int map = wc >> 1, axis = wc & 1;
            bf16* dst = isq ? Q : K; float mx[2] = {0.f, 0.f};
#pragma unroll
            for (int ai = 0; ai < 2; ++ai)
#pragma unroll
                for (int m = 0; m < 4; ++m) { const int t = t0 + ai * 128 + m * 16; const int pos = isctx ? SEQ + t : t;
                    f32x4 cs = (f32x4){1.f, 1.f, 1.f, 1.f}, sn = (f32x4){0.f, 0.f, 0.f, 0.f};
                    if (!isctx) { const int pa = axis ? (t & 63) : (t >> 6); cs = *(const f32x4*)(rope + pa * 16 + 4 * fq); sn = *(const f32x4*)(rope + 2048 + pa * 16 + 4 * fq); }
#pragma unroll
                    for (int bj = 0; bj < 2; ++bj) { const int h = 2 * hp + bj; const f32x4 x1 = acc[ai][bj][m][0], x2 = acc[ai][bj][m][1];
                        f32x4 o1 = x1 * cs - x2 * sn, o2 = x2 * cs + x1 * sn;
                        if (isq) { o1 = o1 * QSCALE; o2 = o2 * QSCALE; }
                        else { float ss = (o1[0] * o1[0] + o1[1] * o1[1]) + (o1[2] * o1[2] + o1[3] * o1[3]) + (o2[0] * o2[0] + o2[1] * o2[1]) + (o2[2] * o2[2] + o2[3] * o2[3]);
                            ss += __shfl_xor(ss, 16); ss += __shfl_xor(ss, 32); mx[bj] = fmaxf(mx[bj], ss); }
                        u32x2 w1, w2; w1.x = pg8::cvt_pk_bf16(o1[0], o1[1]); w1.y = pg8::cvt_pk_bf16(o1[2], o1[3]); w2.x = pg8::cvt_pk_bf16(o2[0], o2[1]); w2.y = pg8::cvt_pk_bf16(o2[2], o2[3]);
                        if (isq) { bf16* rowp = dst + ((size_t)((b * 4 + h) * 2 + map) * KEYS + pos) * 64 + 32 * axis + 4 * fq; *(u32x2*)rowp = w1; *(u32x2*)(rowp + 16) = w2; }
                        else {
                            bf16* rowp = dst + (((((size_t)(b * 4 + h) * 132 + (pos >> 6)) * 2 + map) * 8 + 4 * axis + (fq >> 1)) * 64 + (pos & 63)) * 8 + 4 * (fq & 1);
                            *(u32x2*)rowp = w1; *(u32x2*)(rowp + 2 * 512) = w2; } } }
            if (!isq) {
#pragma unroll
                for (int bj = 0; bj < 2; ++bj) { float mm = mx[bj]; mm = fmaxf(mm, __shfl_xor(mm, 1)); mm = fmaxf(mm, __shfl_xor(mm, 2)); mm = fmaxf(mm, __shfl_xor(mm, 4)); mm = fmaxf(mm, __shfl_xor(mm, 8));
                    if (fr == 0 && fq == 0) atomicMax(kmax + ((b * 4 + 2 * hp + bj) * 2 + map) * 2 + axis, __float_as_uint(mm)); }
            }
        } else if (pn < 4) {
#pragma unroll
            for (int ai = 0; ai < 2; ++ai)
#pragma unroll
                for (int m = 0; m < 4; ++m) { const int t = t0 + ai * 128 + m * 16; const int pos = isctx ? SEQ + t : t;
                    const int pp = (pos & ~12) | ((pos & 4) << 1) | ((pos & 8) >> 1);
#pragma unroll
                    for (int bj = 0; bj < 2; ++bj) { const int h = 2 * (pn - 2) + bj;
#pragma unroll
                        for (int n = 0; n < 2; ++n) { const f32x4 v = acc[ai][bj][m][n]; const int d = wc * 32 + n * 16 + 4 * fq;
#pragma unroll
                            for (int i = 0; i < 4; ++i) Vt[((((size_t)(b * 4 + h) * 132 + (pp >> 6)) * 8 + ((pp & 63) >> 3)) * 128 + d + i) * 8 + (pp & 7)] = f2bf(v[i]); } } }
        } else if (pn < 8) { rowmajor<1>(acc, ga, 512, (pn - 6) * 256, row0, wc, fq);
        } else if (pn < 14) { if (isctx) transposed<0>(acc, zhyTc + (size_t)b * 1536 * CTXL, CTXL, (pn - 8) * 256, t0, wc, fq); else transposed<0>(acc, zhyT + (size_t)b * 1536 * SEQ, SEQ, (pn - 8) * 256, t0, wc, fq);
        } else if (pn < 16) { if (isctx) transposed<1>(acc, gbTc + (size_t)b * 512 * CTXL, CTXL, (pn - 14) * 256, t0, wc, fq); else transposed<1>(acc, gbT + (size_t)b * 512 * SEQ, SEQ, (pn - 14) * 256, t0, wc, fq);
        } else if (pn < 20) { rowmajor<2>(acc, zgm, 1024, (pn - 16) * 256, row0, wc, fq);
        } else if (pn < 22) { rowmajor<1>(acc, gc, 512, (pn - 20) * 256, row0, wc, fq);
        } else { rowmajor<3>(acc, sel, 3072, (pn - 22) * 256, row0, wc, fq); }
    }
};
struct MergeHook {
    static constexpr bool ON = true; const bf16* sel;
    __device__ __forceinline__ void operator()(f32x4 (&acc)[2][2][4][2], const pg8::Unit& u, int wr, int wc, int fr, int fq, int t) const {
        asm volatile("" : "+v"(fr), "+v"(fq));
        const int i = t >> 3;
        const int row0 = u.pm * 256 + wr * 64 + fr, col0 = u.pn * 256 + wc * 32 + 4 * fq;
#pragma unroll
        for (int ai = 0; ai < 2; ++ai)
#pragma unroll
            for (int m = 0; m < 4; ++m) { const bf16* sp = sel + (size_t)(row0 + ai * 128 + m * 16) * 3072 + (i - 1) * 1024 + col0;
#pragma unroll
                for (int bj = 0; bj < 2; ++bj)
#pragma unroll
                    for (int n = 0; n < 2; ++n) { const u32x2 a = *(const u32x2*)(sp + bj * 128 + n * 16), b = *(const u32x2*)(sp + 1024 + bj * 128 + n * 16);
                        f32x4 r; r[0] = bf2f(a.x & 0xffffu) * __builtin_amdgcn_rcpf(fmaxf(bf2f(b.x & 0xffffu), 1e-30f)); r[1] = bf2f(a.x >> 16) * __builtin_amdgcn_rcpf(fmaxf(bf2f(b.x >> 16), 1e-30f));
                        r[2] = bf2f(a.y & 0xffffu) * __builtin_amdgcn_rcpf(fmaxf(bf2f(b.y & 0xffffu), 1e-30f)); r[3] = bf2f(a.y >> 16) * __builtin_amdgcn_rcpf(fmaxf(bf2f(b.y >> 16), 1e-30f));
                        acc[ai][bj][m][n] = acc[ai][bj][m][n] * r; }
                asm volatile("" ::: "memory"); }
    }
};
struct EpiMergeF {
    static constexpr bool PERM = false, AFTER_DRAIN = false;
    const bf16* sel; bf16* outpre;
    __device__ __forceinline__ void operator()(const f32x4 (&acc)[2][2][4][2], const pg8::Unit& u, int wr, int wc, int fr, int fq) const {
        asm volatile("" : "+v"(fr), "+v"(fq));
        const int row0 = u.pm * 256 + wr * 64 + fr, col0 = u.pn * 256 + wc * 32 + 4 * fq;
#pragma unroll
        for (int ai = 0; ai < 2; ++ai)
#pragma unroll
            for (int m = 0; m < 4; ++m) { const size_t row = row0 + ai * 128 + m * 16;
#pragma unroll
                for (int bj = 0; bj < 2; ++bj)
#pragma unroll
                    for (int n = 0; n < 2; ++n) { const int col = col0 + bj * 128 + n * 16;
                        const u32x2 sr = *(const u32x2*)(sel + row * 3072 + 2048 + col);
                        f32x4 v = acc[ai][bj][m][n]; v[0] *= bf2f(sr.x & 0xffffu); v[1] *= bf2f(sr.x >> 16); v[2] *= bf2f(sr.y & 0xffffu); v[3] *= bf2f(sr.y >> 16);
                        u32x2 w; w.x = pg8::cvt_pk_bf16(v[0], v[1]); w.y = pg8::cvt_pk_bf16(v[2], v[3]); *(u32x2*)(outpre + row * 1024 + col) = w; } }
    }
};
struct EpiOut {
    static constexpr bool PERM = false, AFTER_DRAIN = false;
    bf16* out; int last;
    __device__ __forceinline__ void operator()(const f32x4 (&acc)[2][2][4][2], const pg8::Unit& u, int wr, int wc, int fr, int fq) const {
        if (u.pm >= 64 && last) return;
        asm volatile("" : "+v"(fr), "+v"(fq));
        const int row0 = u.pm * 256 + wr * 64 + fr, col0 = u.pn * 256 + wc * 32 + 4 * fq;
#pragma unroll
        for (int ai = 0; ai < 2; ++ai)
#pragma unroll
            for (int m = 0; m < 4; ++m)
#pragma unroll
                for (int bj = 0; bj < 2; ++bj)
#pragma unroll
                    for (int n = 0; n < 2; ++n) { const f32x4 v = acc[ai][bj][m][n]; u32x2 w; w.x = pg8::cvt_pk_bf16(v[0], v[1]); w.y = pg8::cvt_pk_bf16(v[2], v[3]); *(u32x2*)(out + (size_t)(row0 + ai * 128 + m * 16) * 1024 + col0 + bj * 128 + n * 16) = w; }
    }
};
__device__ __forceinline__ void phase0(const Params& p, int wid0) {
    MK_TIDS(wid0)
    unsigned char* ws = p.ws;
    if (blockIdx.x == 0 && tid < 128) ((unsigned*)(ws + WS_CTL))[tid] = 0u;
    { const int gid = blockIdx.x * 512 + tid;
      if (gid < 2048) { const int pa = gid >> 4, f = gid & 15; const float inv = exp2f(-(float)f * (13.287712379549449f / 16.f)); const float ang = (float)pa * inv;
          float* rope = (float*)(ws + WS_ROPE); rope[gid] = cosf(ang); rope[2048 + gid] = sinf(ang); } }
    const int gw = blockIdx.x * 8 + wid, NGW = gridDim.x * 8;
    float* modp = (float*)(ws + WS_MODP);
    for (int it = gw; it < DEPTH * 48 * 8; it += NGW) {
        const int kc = it & 7, cb = (it >> 3) % 48, l = it / (48 * 8); const int col = cb * 64 + lane;
        float sv[3][2];
#pragma unroll
        for (int j = 0; j < 2; ++j) { const int k = kc * 128 + j * 64 + lane;
            sv[0][j] = silu_f(p.in[I_C][k]); sv[1][j] = silu_f(p.in[I_C][1024 + k]); sv[2][j] = silu_f(p.in[I_CCTX][k]); }
        float a0 = 0.f, a1 = 0.f, a2 = 0.f;
        const float* W = p.in[I_ADAW] + ((size_t)l * 1024 + kc * 128) * 3072 + col;
#pragma unroll
        for (int j = 0; j < 2; ++j)
#pragma unroll 16
            for (int kk = 0; kk < 64; ++kk) { const float w = W[(size_t)(j * 64 + kk) * 3072];
                a0 += __shfl(sv[0][j], kk) * w; a1 += __shfl(sv[1][j], kk) * w; a2 += __shfl(sv[2][j], kk) * w; }
        if (kc == 0) { const float bb = p.in[I_ADAB][l * 3072 + col]; a0 += bb; a1 += bb; a2 += bb; }
        float* o = modp + ((size_t)(kc * DEPTH + l) * 3) * 3072 + col;
        o[0] = a0; o[3072] = a1; o[6144] = a2;
    }
}

__device__ __forceinline__ void transpose_item(const float* W, int K, int N, bf16* WT, int ldt, float* scr, int item, int lane) {
    const int nblk = N / 32, kb = item / nblk, nb = item % nblk, k0 = 64 * kb, n0 = 32 * nb;
#pragma unroll 8
    for (int i = 0; i < 32; ++i) { const int kk = 2 * i + (lane >> 5); scr[kk * 33 + (lane & 31)] = W[(size_t)(k0 + kk) * N + n0 + (lane & 31)]; }
    __builtin_amdgcn_s_waitcnt(0); asm volatile("" ::: "memory");
    const int c = lane & 7;
#pragma unroll
    for (int j = 0; j < 4; ++j) { const int n = (lane >> 3) + 8 * j; const float* s = scr + (8 * c) * 33 + n;
        u32x4 o; o.x = pg8::cvt_pk_bf16(s[0 * 33], s[1 * 33]); o.y = pg8::cvt_pk_bf16(s[2 * 33], s[3 * 33]); o.z = pg8::cvt_pk_bf16(s[4 * 33], s[5 * 33]); o.w = pg8::cvt_pk_bf16(s[6 * 33], s[7 * 33]);
        *(u32x4*)(WT + (size_t)(n0 + n) * ldt + k0 + 8 * c) = o; }
    __builtin_amdgcn_s_waitcnt(0); asm volatile("" ::: "memory");
}
__device__ __forceinline__ void filter_item(const Params& p, int l, int Lf, int t0, float* dst, float* hidT  , int wid0) {
    MK_TIDS(wid0)
    const float* w1 = p.in[I_FW1] + l * 33 * 64; const float* b1 = p.in[I_FB1] + l * 64; const float* w2 = p.in[I_FW2] + l * 64 * 64; const float* b2 = p.in[I_FB2] + l * 64;
    const float* w3 = p.in[I_FW3] + (size_t)l * 64 * 1024; const float* fq = p.in[I_FFREQ] + l * 128;
    const float f0 = fq[lane], f1 = fq[64 + lane], bb1 = b1[lane], bb2 = b2[lane];
    float* w1s = hidT + 2048; float* w2s = w1s + 33 * 64;
    { float t1[5], t2[8];
#pragma unroll
      for (int k = 0; k < 5; ++k) { const int idx = tid + 512 * k; t1[k] = idx < 33 * 64 ? w1[idx] : 0.f; }
#pragma unroll
      for (int k = 0; k < 8; ++k) t2[k] = w2[tid + 512 * k];
#pragma unroll
      for (int k = 0; k < 5; ++k) { const int idx = tid + 512 * k; if (idx < 33 * 64) w1s[idx] = t1[k]; }
#pragma unroll
      for (int k = 0; k < 8; ++k) w2s[tid + 512 * k] = t2[k]; }
    __syncthreads();
    { float z[4], a[4], c[4];
#pragma unroll
      for (int pp = 0; pp < 4; ++pp) { const int t = t0 + 4 * wid + pp;
        const float tn = (float)t / (float)(Lf - 1); const float wpos = (6.283185307179586f / (float)Lf) * (float)t;
        float zz = 0.f;
        if (lane == 0) zz = tn;
        else if (lane <= 16) { const float band = 1e-4f + (float)(lane - 1) * ((15.f - 1e-4f) / 15.f); zz = cosf(band * wpos); }
        else if (lane <= 32) { const float band = 1e-4f + (float)(lane - 17) * ((15.f - 1e-4f) / 15.f); zz = -sinf(band * wpos); }
        z[pp] = zz; a[pp] = bb1; c[pp] = bb2; }
#pragma unroll 3
      for (int e = 0; e < 33; ++e) { const float w = w1s[e * 64 + lane];
#pragma unroll
        for (int pp = 0; pp < 4; ++pp) a[pp] += __shfl(z[pp], e) * w; }
#pragma unroll
      for (int pp = 0; pp < 4; ++pp) a[pp] = sinf(f0 * a[pp]);
#pragma unroll 4
      for (int i = 0; i < 64; ++i) { const float w = w2s[i * 64 + lane];
#pragma unroll
        for (int pp = 0; pp < 4; ++pp) c[pp] += __shfl(a[pp], i) * w; }
#pragma unroll
      for (int pp = 0; pp < 4; ++pp) hidT[lane * 32 + 4 * wid + pp] = sinf(f1 * c[pp]); }
    __syncthreads();
    float acc0[32], acc1[32];
#pragma unroll
    for (int i = 0; i < 32; ++i) { acc0[i] = 0.f; acc1[i] = 0.f; }
#pragma unroll 16
    for (int j = 0; j < 64; ++j) {
        const float wa = w3[j * 1024 + tid], wb = w3[j * 1024 + 512 + tid];
#pragma unroll
        for (int g = 0; g < 8; ++g) { const f32x4 hv = *(const f32x4*)(hidT + j * 32 + 4 * g);
#pragma unroll
            for (int i = 0; i < 4; ++i) { acc0[4 * g + i] += hv[i] * wa; acc1[4 * g + i] += hv[i] * wb; } }
    }
    const float dmin = -3.0701134573253945f, dmax = -15.350567286626973f;
    const float delta = fabsf(dmin + (float)tid * ((dmax - dmin) / 511.f));
#pragma unroll
    for (int g = 0; g < 8; ++g) { f32x4 o0, o1;
#pragma unroll
        for (int i = 0; i < 4; ++i) { const float tn = (float)(t0 + 4 * g + i) / (float)(Lf - 1); const float wdw = __expf(-tn * delta); o0[i] = acc0[4 * g + i] * wdw; o1[i] = acc1[4 * g + i] * wdw; }
        *(f32x4*)(dst + (size_t)tid * Lf + t0 + 4 * g) = o0; *(f32x4*)(dst + (size_t)(512 + tid) * Lf + t0 + 4 * g) = o1; }
    __syncthreads();
}
__device__ __forceinline__ void phaseA(const Params& p, int l, unsigned char* lds, int wid0) {
    MK_TIDS(wid0)
    unsigned char* ws = p.ws;
    float* vA = (float*)lds; float* vSH = vA + 3072; float* vGTP = vSH + 3072;
    const float* modp = (const float*)(ws + WS_MODP);
    for (int idx = tid; idx < 3072; idx += 512) { const int cond = idx >> 10, col = idx & 1023;
        if (l < DEPTH) { float sh = 0.f, sc = 0.f;
#pragma unroll
            for (int kc = 0; kc < 8; ++kc) { const float* o = modp + ((size_t)(kc * DEPTH + l) * 3 + cond) * 3072; sh += o[col]; sc += o[1024 + col]; }
            vA[idx] = p.in[I_NPRE][l * 1024 + col] * (1.f + sc); vSH[idx] = sh; }
        if (l > 0) { float gt = 0.f;
#pragma unroll
            for (int kc = 0; kc < 8; ++kc) gt += modp[((size_t)(kc * DEPTH + (l - 1)) * 3 + cond) * 3072 + 2048 + col];
            vGTP[idx] = gt * p.in[I_NPOST][(l - 1) * 1024 + col]; } }
    __syncthreads();
    const int gw = blockIdx.x * 8 + wid, NGW = gridDim.x * 8;
    const bf16* outb = (const bf16*)(ws + WS_OUT); bf16* hb = (bf16*)(ws + WS_H); float* xc = (float*)(ws + WS_XC);
    const int nrows = (l < DEPTH) ? MROWS : MLAT;
    for (int r0 = gw; r0 < nrows; r0 += 2 * NGW) {
        const int r1 = r0 + NGW; const bool two = r1 < nrows;
        f32x4 v[2][4], o[2][4]; const float* xs[2]; float* xd[2]; int cond[2]; int rr[2] = {r0, two ? r1 : r0};
#pragma unroll
        for (int k = 0; k < 2; ++k) { const int r = rr[k]; const bool isctx = r >= MLAT; cond[k] = isctx ? 2 : (r >> 13);
            if (!isctx) { xs[k] = (l <= 1 ? p.in[I_X] : p.out) + (size_t)r * 1024; xd[k] = p.out + (size_t)r * 1024; }
            else { xs[k] = (l <= 1 ? p.in[I_CTX] : xc) + (size_t)(r - MLAT) * 1024; xd[k] = xc + (size_t)(r - MLAT) * 1024; }
#pragma unroll
            for (int j = 0; j < 4; ++j) v[k][j] = *(const f32x4*)(xs[k] + 4 * lane + 256 * j);
            if (l > 0) {
#pragma unroll
                for (int j = 0; j < 4; ++j) { const u32x2 w = *(const u32x2*)(outb + (size_t)r * 1024 + 4 * lane + 256 * j); o[k][j] = (f32x4){bf2f(w.x & 0xffffu), bf2f(w.x >> 16), bf2f(w.y & 0xffffu), bf2f(w.y >> 16)}; } } }
        if (l > 0) { float ss[2];
#pragma unroll
            for (int k = 0; k < 2; ++k) { ss[k] = 0.f;
#pragma unroll
                for (int j = 0; j < 4; ++j) ss[k] += (o[k][j][0] * o[k][j][0] + o[k][j][1] * o[k][j][1]) + (o[k][j][2] * o[k][j][2] + o[k][j][3] * o[k][j][3]); }
            ss[0] = wave_sum(ss[0]); ss[1] = wave_sum(ss[1]);
#pragma unroll
            for (int k = 0; k < 2; ++k) { const float rinv = rsqrtf(ss[k] * (1.f / 1024.f) + EPSN);
                if (k == 0 || two) {
#pragma unroll
                    for (int j = 0; j < 4; ++j) { const f32x4 g = *(const f32x4*)(vGTP + cond[k] * 1024 + 4 * lane + 256 * j); v[k][j] = v[k][j] + g * o[k][j] * rinv; *(f32x4*)(xd[k] + 4 * lane + 256 * j) = v[k][j]; } } } }
        if (l < DEPTH) { float ss[2];
#pragma unroll
            for (int k = 0; k < 2; ++k) { ss[k] = 0.f;
#pragma unroll
                for (int j = 0; j < 4; ++j) ss[k] += (v[k][j][0] * v[k][j][0] + v[k][j][1] * v[k][j][1]) + (v[k][j][2] * v[k][j][2] + v[k][j][3] * v[k][j][3]); }
            ss[0] = wave_sum(ss[0]); ss[1] = wave_sum(ss[1]);
#pragma unroll
            for (int k = 0; k < 2; ++k) { const float rinv = rsqrtf(ss[k] * (1.f / 1024.f) + EPSN);
                if (k == 0 || two) {
#pragma unroll
                    for (int j = 0; j < 4; ++j) { const f32x4 a = *(const f32x4*)(vA + cond[k] * 1024 + 4 * lane + 256 * j), sh = *(const f32x4*)(vSH + cond[k] * 1024 + 4 * lane + 256 * j);
                        const f32x4 h = v[k][j] * rinv * a + sh; u32x2 w; w.x = pg8::cvt_pk_bf16(h[0], h[1]); w.y = pg8::cvt_pk_bf16(h[2], h[3]); *(u32x2*)(hb + (size_t)rr[k] * 1024 + 4 * lane + 256 * j) = w; } } } }
    }
    if (l >= DEPTH) return;
    for (int rep = 0; rep < REP_A2; ++rep) {
    { float* scr = (float*)(lds + 36864 + wid * 8448);
      constexpr int I_IN = 16 * 272, I_BR = 8 * 32, I_O = 16 * 32;
      for (int it = gw; it < I_IN + 3 * I_BR + I_O; it += NGW) { int r = it;
          if (r < I_IN) { transpose_item(p.in[I_WIN] + (size_t)l * 1024 * NCOL, 1024, NCOL, (bf16*)(ws + WS_WIN), 1024, scr, r, lane); continue; } r -= I_IN;
          if (r < 3 * I_BR) { const int i = r / I_BR; transpose_item(p.in[I_WBR] + ((size_t)l * 3 + i) * 512 * 1024, 512, 1024, (bf16*)(ws + WS_WBR) + (size_t)i * 512, 1536, scr, r % I_BR, lane); continue; } r -= 3 * I_BR;
          transpose_item(p.in[I_WOUT] + (size_t)l * 1024 * 1024, 1024, 1024, (bf16*)(ws + WS_WOUT), 1024, scr, r, lane); } }
    { float* hidT = (float*)(lds + 104448);
      for (int it = blockIdx.x; it < 256; it += gridDim.x) filter_item(p, l, SEQ, 32 * it, (float*)(ws + WS_FILT), hidT, wid0);
      }
    __syncthreads();
    }
}
__device__ __forceinline__ float sumsq8(bf16x8 v) { float s = 0.f;
#pragma unroll
    for (int j = 0; j < 8; ++j) { const float f = bf2f((unsigned)(unsigned short)v[j]); s += f * f; } return s; }
__device__ __forceinline__ bf16x8 pack8(const f32x16& S, int o) { u32x4 w; w.x = pg8::cvt_pk_bf16(S[o + 0], S[o + 1]); w.y = pg8::cvt_pk_bf16(S[o + 2], S[o + 3]); w.z = pg8::cvt_pk_bf16(S[o + 4], S[o + 5]); w.w = pg8::cvt_pk_bf16(S[o + 6], S[o + 7]); return __builtin_bit_cast(bf16x8, w); }
__device__ __forceinline__ void attn_unit(const Params& p, int l, int b, int h, int qpos0, int kbeg, int nkt, int grow0, float lam, float lam_init, unsigned char* lds, int wid0) {
    MK_TIDS(wid0)
    unsigned char* ws = p.ws;
    const bf16* Q = (const bf16*)(ws + WS_Q); const bf16* K = (const bf16*)(ws + WS_K); const bf16* Vt = (const bf16*)(ws + WS_VT);
    const bf16* ga = (const bf16*)(ws + WS_GA); bf16* gated = (bf16*)(ws + WS_GATED);
    const unsigned* kmax = (const unsigned*)(ws + WS_CTL) + l * 32;
    const int r32 = lane & 31, hi = lane >> 5, bh = b * 4 + h, qg = wid >> 1, map = wid & 1;
    bf16x8 qf[4]; float Msh;
    { const bf16* qp = Q + ((size_t)(bh * 2 + map) * KEYS + qpos0 + qg * 32 + r32) * 64 + hi * 8;
#pragma unroll
        for (int s = 0; s < 4; ++s) qf[s] = *(const bf16x8*)(qp + 16 * s);
        float nA = sumsq8(qf[0]) + sumsq8(qf[1]), nB = sumsq8(qf[2]) + sumsq8(qf[3]);
        nA += __shfl_xor(nA, 32); nB += __shfl_xor(nB, 32);
        const float kA = __uint_as_float(kmax[(bh * 2 + map) * 2 + 0]), kB = __uint_as_float(kmax[(bh * 2 + map) * 2 + 1]);
        Msh = sqrtf(nA * kA) + sqrtf(nB * kB); }
    f32x16 o[4];
#pragma unroll
    for (int db = 0; db < 4; ++db)
#pragma unroll
        for (int r = 0; r < 16; ++r) o[db][r] = 0.f;
    float lsum = 0.f;
    LAS unsigned char* ldsl = (LAS unsigned char*)lds;
    const bf16* kt_g = K + (size_t)bh * 132 * 8192 + (size_t)(2 * wid) * 512 + lane * 8; const bf16* vt_g = Vt + (size_t)bh * 132 * 8192 + (size_t)(2 * wid) * 512 + lane * 8;
#define AT_DMA(tile, buf) do { const bf16* kp_ = kt_g + (size_t)(tile) * 8192; const bf16* vp_ = vt_g + (size_t)(tile) * 8192; LAS unsigned char* lb_ = ldsl + (buf) * 32768 + (2 * wid) * 1024; \
        __builtin_amdgcn_global_load_lds((const unsigned*)kp_, (LAS unsigned*)lb_, 16, 0, 0); __builtin_amdgcn_global_load_lds((const unsigned*)(kp_ + 512), (LAS unsigned*)(lb_ + 1024), 16, 0, 0); \
        __builtin_amdgcn_global_load_lds((const unsigned*)vp_, (LAS unsigned*)(lb_ + 16384), 16, 0, 0); __builtin_amdgcn_global_load_lds((const unsigned*)(vp_ + 512), (LAS unsigned*)(lb_ + 16384 + 1024), 16, 0, 0); } while (0)
    const int kt0 = kbeg >> 6;
#define AT_LDK(bufoff, kbi) do { _Pragma("unroll") for (int s_ = 0; s_ < 4; ++s_) kf[s_] = *(const LAS bf16x8*)(kl_ + (bufoff) + ((2 * s_) * 64 + 32 * (kbi)) * 16); } while (0)
#define AT_LDV(bufoff, kbi) do { _Pragma("unroll") for (int db_ = 0; db_ < 4; ++db_) { vf[2 * db_] = *(const LAS bf16x8*)(vl_ + (bufoff) + ((4 * (kbi)) * 128 + 32 * db_) * 16); vf[2 * db_ + 1] = *(const LAS bf16x8*)(vl_ + (bufoff) + ((4 * (kbi) + 2) * 128 + 32 * db_) * 16); } } while (0)
#define AT_MQK(dst) do { dst = __builtin_amdgcn_mfma_f32_32x32x16_bf16(kf[0], qf[0], negm, 0, 0, 0); _Pragma("unroll") for (int s_ = 1; s_ < 4; ++s_) dst = __builtin_amdgcn_mfma_f32_32x32x16_bf16(kf[s_], qf[s_], dst, 0, 0, 0); } while (0)
#define AT_MPV(pk0_, pk1_) do { _Pragma("unroll") for (int db_ = 0; db_ < 4; ++db_) { o[db_] = __builtin_amdgcn_mfma_f32_32x32x16_bf16(pk0_, vf[2 * db_], o[db_], 0, 0, 0); o[db_] = __builtin_amdgcn_mfma_f32_32x32x16_bf16(pk1_, vf[2 * db_ + 1], o[db_], 0, 0, 0); } } while (0)
#define AT_SM(src, pk0_, pk1_) do { float ls_ = 0.f; _Pragma("unroll") for (int r_ = 0; r_ < 16; ++r_) { src[r_] = __builtin_amdgcn_exp2f(src[r_]); ls_ += src[r_]; } lsum += ls_; pk0_ = pack8(src, 0); pk1_ = pack8(src, 8); } while (0)
#define AT_SB() __builtin_amdgcn_sched_barrier(0)
    const LAS unsigned char* kl_ = ldsl + ((map * 8 + hi) * 64 + r32) * 16; const LAS unsigned char* vl_ = ldsl + 16384 + (hi * 128 + r32) * 16;
    AT_DMA(kt0, 0); if (nkt > 1) AT_DMA(kt0 + 1, 1); if (nkt > 2) AT_DMA(kt0 + 2, 2);
    asm volatile("s_waitcnt vmcnt(0)" ::: "memory"); __syncthreads();
    f32x16 Sc, Sn, negm; bf16x8 kf[4], vf[8];
#pragma unroll
    for (int r = 0; r < 16; ++r) negm[r] = -Msh;
    asm volatile("" : "+v"(negm));
    AT_LDK(0, 0); AT_MQK(Sc);
    bf16x8 pA0, pA1, pB0, pB1;
#pragma unroll
    for (int j = 0; j < 8; ++j) { pA0[j] = 0; pA1[j] = 0; }
    int bop = 98304, bo = 0, bo1 = 32768, bo2 = 65536;
    for (int it = 0; it < nkt; ++it) {
        AT_LDK(bo, 1); AT_LDV((it ? bop : bo), 1); AT_SB();
        AT_SM(Sc, pB0, pB1); AT_SB();
        __builtin_amdgcn_s_setprio(1); AT_MQK(Sn); AT_MPV(pA0, pA1); __builtin_amdgcn_s_setprio(0); AT_SB();
        if (it + 2 < nkt) asm volatile("s_waitcnt vmcnt(4)" ::: "memory"); else asm volatile("s_waitcnt vmcnt(0)" ::: "memory");
        __syncthreads();
        if (it + 3 < nkt) AT_DMA(kt0 + it + 3, (bop >> 15));
        if (it + 1 < nkt) AT_LDK(bo1, 0);
        AT_LDV(bo, 0); AT_SB();
        AT_SM(Sn, pA0, pA1); AT_SB();
        __builtin_amdgcn_s_setprio(1); if (it + 1 < nkt) AT_MQK(Sc);
        AT_MPV(pB0, pB1); __builtin_amdgcn_s_setprio(0); AT_SB();
        const int tb = bop; bop = bo; bo = bo1; bo1 = bo2; bo2 = tb;
    }
    AT_LDV(bop, 1); AT_MPV(pA0, pA1);
    __syncthreads();
#undef AT_LDK
#undef AT_LDV
#undef AT_MQK
#undef AT_MPV
#undef AT_SM
#undef AT_SB
#undef AT_DMA
    lsum += __shfl_xor(lsum, 32);
    float* wsf = (float*)(lds + 131072) + wid * 32;
    if (hi == 0) wsf[r32] = (map == 0 ? 1.f : lam) / lsum;
    __builtin_amdgcn_s_waitcnt(0); asm volatile("" ::: "memory");
    float* xch = (float*)lds + qg * (32 * 132);
    if (map == 1) {
#pragma unroll
        for (int r = 0; r < 16; ++r) { const int q = crow(r, hi); const float c = wsf[q];
#pragma unroll
            for (int db = 0; db < 4; ++db) xch[q * 132 + 32 * db + r32] = o[db][r] * c; }
    }
    __syncthreads();
    if (map == 0) {
        const float* sg = p.in[I_SUBLN] + l * 128; float g4[4];
#pragma unroll
        for (int db = 0; db < 4; ++db) g4[db] = sg[32 * db + r32] * (1.f - lam_init);
        bf16 gv[16][4];
#pragma unroll
        for (int r = 0; r < 16; ++r) { const size_t grow = (size_t)grow0 + qg * 32 + crow(r, hi);
#pragma unroll
            for (int db = 0; db < 4; ++db) gv[r][db] = ga[grow * 512 + h * 128 + 32 * db + r32]; }
#pragma unroll
        for (int r = 0; r < 16; ++r) { const int q = crow(r, hi); const float a = wsf[q]; float v[4]; float ss = 0.f;
#pragma unroll
            for (int db = 0; db < 4; ++db) { v[db] = o[db][r] * a - xch[q * 132 + 32 * db + r32]; ss += v[db] * v[db]; }
            ss += __shfl_xor(ss, 1); ss += __shfl_xor(ss, 2); ss += __shfl_xor(ss, 4); ss += __shfl_xor(ss, 8); ss += __shfl_xor(ss, 16);
            const float rinv = rsqrtf(ss * (1.f / 128.f) + EPSN); const size_t grow = (size_t)grow0 + qg * 32 + q;
#pragma unroll
            for (int db = 0; db < 4; ++db) { const int col = h * 128 + 32 * db + r32; gated[grow * 1536 + col] = f2bf(v[db] * rinv * g4[db] * bf2f(gv[r][db])); } }
    }
    __syncthreads();
}

struct cf { float x, y; };
__device__ __forceinline__ cf cadd(cf a, cf b) { return {a.x + b.x, a.y + b.y}; }
__device__ __forceinline__ cf csub(cf a, cf b) { return {a.x - b.x, a.y - b.y}; }
__device__ __forceinline__ cf cmul(cf a, cf b) { return {a.x * b.x - a.y * b.y, a.x * b.y + a.y * b.x}; }
__device__ __forceinline__ cf cmulc(cf a, cf b) { return {a.x * b.x + a.y * b.y, a.y * b.x - a.x * b.y}; }
template <bool INV> __device__ __forceinline__ void dft4(cf& a0, cf& a1, cf& a2, cf& a3) {
    const cf t0 = cadd(a0, a2), t1 = csub(a0, a2), t2 = cadd(a1, a3), t3 = csub(a1, a3);
    a0 = cadd(t0, t2); a2 = csub(t0, t2);
    if (!INV) { a1 = {t1.x + t3.y, t1.y - t3.x}; a3 = {t1.x - t3.y, t1.y + t3.x}; }
    else      { a1 = {t1.x - t3.y, t1.y + t3.x}; a3 = {t1.x + t3.y, t1.y - t3.x}; }
}
#define W16C(m) ((m) == 0 ? 1.f : (m) == 1 ? 0.9238795325112867f : (m) == 2 ? 0.7071067811865476f : (m) == 3 ? 0.3826834323650898f : (m) == 4 ? 0.f : (m) == 6 ? -0.7071067811865476f : (m) == 9 ? -0.9238795325112867f : 0.f)
#define W16S(m) ((m) == 0 ? 0.f : (m) == 1 ? 0.3826834323650898f : (m) == 2 ? 0.7071067811865476f : (m) == 3 ? 0.9238795325112867f : (m) == 4 ? 1.f : (m) == 6 ? 0.7071067811865476f : (m) == 9 ? -0.3826834323650898f : 0.f)
template <bool INV> __device__ __forceinline__ void dft16(cf (&a)[16]) {
#pragma unroll
    for (int n2 = 0; n2 < 4; ++n2) dft4<INV>(a[n2], a[4 + n2], a[8 + n2], a[12 + n2]);
#pragma unroll
    for (int k1 = 1; k1 < 4; ++k1)
#pragma unroll
        for (int n2 = 1; n2 < 4; ++n2) { const cf w = {W16C(n2 * k1), W16S(n2 * k1)};
            a[4 * k1 + n2] = INV ? cmul(a[4 * k1 + n2], w) : cmulc(a[4 * k1 + n2], w); }
#pragma unroll
    for (int k1 = 0; k1 < 4; ++k1) dft4<INV>(a[4 * k1 + 0], a[4 * k1 + 1], a[4 * k1 + 2], a[4 * k1 + 3]);
}
__device__ __forceinline__ int fidx(int e) { return e + ((e >> 6) << 2); }
template <bool INV, int LQ, bool PRUNE = false> __device__ __forceinline__ void fft_pass16(f32x2* X, int tid) {
    constexpr int q = 1 << LQ, STR = q + 4 * (q >> 6);
#pragma unroll 1
    for (int gg = 0; gg < 2; ++gg) {
        const int g = tid + 512 * gg, blk = g >> LQ, i = g & (q - 1), base = (blk << (LQ + 4)) + i;
        f32x2* xb = X + fidx(base);
        cf a[16];
#pragma unroll
        for (int j = 0; j < 16; ++j) { if (PRUNE && !INV && j >= 8) { a[j] = {0.f, 0.f}; } else { const f32x2 v = xb[j * STR]; a[j] = {v.x, v.y}; } }
        const float rev = (float)i * (1.f / (float)(16 << LQ));
        const cf w1 = {__builtin_amdgcn_cosf(rev), __builtin_amdgcn_sinf(rev)};
        if (!INV) {
            dft16<false>(a);
            cf w = w1;
#pragma unroll
            for (int k = 1; k < 16; ++k) { const int src = 4 * (k & 3) + (k >> 2);
                const cf y = cmulc(a[src], w); xb[k * STR] = (f32x2){y.x, y.y}; w = cmul(w, w1); }
            xb[0] = (f32x2){a[0].x, a[0].y};
        } else {
            cf w = w1;
#pragma unroll
            for (int k = 1; k < 16; ++k) { a[k] = cmul(a[k], w); w = cmul(w, w1); }
            dft16<true>(a);
#pragma unroll
            for (int k = 0; k < (PRUNE ? 8 : 16); ++k) { const int src = 4 * (k & 3) + (k >> 2); xb[k * STR] = (f32x2){a[src].x, a[src].y}; }
        }
    }
}
template <bool INV> __device__ __forceinline__ void fft_pass4(f32x2* X, int tid) {
#pragma unroll 4
    for (int gg = 0; gg < 8; ++gg) { const int g = tid + 512 * gg; f32x2* xp = X + fidx(4 * g);
        const f32x4 v01 = *(const f32x4*)xp, v23 = *(const f32x4*)(xp + 2);
        cf a0 = {v01[0], v01[1]}, a1 = {v01[2], v01[3]}, a2 = {v23[0], v23[1]}, a3 = {v23[2], v23[3]};
        dft4<INV>(a0, a1, a2, a3);
        *(f32x4*)xp = (f32x4){a0.x, a0.y, a1.x, a1.y}; *(f32x4*)(xp + 2) = (f32x4){a2.x, a2.y, a3.x, a3.y}; }
}
__device__ __forceinline__ float block_sum(float v, float* red, int lane, int wid) {
    v = wave_sum(v); __syncthreads(); if (lane == 0) red[wid] = v; __syncthreads();
    float s = 0.f;
#pragma unroll
    for (int i = 0; i < 8; ++i) s += red[i];
    return s;
}
__device__ __forceinline__ float zat(const bf16* z, int t, int L) { return (t >= 0 && t < L) ? bf2f(z[t]) : 0.f; }
__device__ __forceinline__ float sconv(const bf16* z, int t, int L, float w0, float w1, float w2, float bb) { return w0 * zat(z, t - 1, L) + w1 * zat(z, t, L) + w2 * zat(z, t + 1, L) + bb; }
__device__ __forceinline__ void ld10(const bf16* row, int t0, float (&o)[10]) {
    const u32x4 raw = *(const u32x4*)(row + t0);
    o[0] = t0 > 0 ? bf2f(row[t0 - 1]) : 0.f; o[9] = t0 + 8 < SEQ ? bf2f(row[t0 + 8]) : 0.f;
    o[1] = bf2f(raw.x & 0xffffu); o[2] = bf2f(raw.x >> 16); o[3] = bf2f(raw.y & 0xffffu); o[4] = bf2f(raw.y >> 16); o[5] = bf2f(raw.z & 0xffffu); o[6] = bf2f(raw.z >> 16); o[7] = bf2f(raw.w & 0xffffu); o[8] = bf2f(raw.w >> 16);
}
__device__ __forceinline__ void hyena_channel(const Params& p, int l, int c, unsigned char* lds, int wid0) {
    MK_TIDS(wid0)
    unsigned char* ws = p.ws;
    f32x2* X = (f32x2*)lds; float* red = (float*)(lds + 139264);
    const float* filt = (const float*)(ws + WS_FILT);
    const float* sw = p.in[I_SW] + l * 3 * 1536; const float* sb = p.in[I_SB] + l * 1536;
    const float w00 = sw[c], w01 = sw[1536 + c], w02 = sw[3072 + c], b0 = sb[c];
    const float w10 = sw[512 + c], w11 = sw[1536 + 512 + c], w12 = sw[3072 + 512 + c], b1 = sb[512 + c];
    const float w20 = sw[1024 + c], w21 = sw[1536 + 1024 + c], w22 = sw[3072 + 1024 + c], b2 = sb[1024 + c];
    const float hbias = p.in[I_HBIAS][l * 512 + c];
    const bf16* zT = (const bf16*)(ws + WS_ZHYT);
    f32x2* Kfg = (f32x2*)(ws + WS_H) + (size_t)blockIdx.x * 16384;
    float ssq = 0.f;
#pragma unroll 1
    for (int it = 0; it < 2; ++it) {
        if (it == 0) {
            const float* ff = filt + (size_t)c * SEQ; const float* fb = filt + (size_t)(512 + c) * SEQ;
#pragma unroll 4
            for (int j = 0; j < 8; ++j) { const int e0 = 4 * tid + 2048 * j; f32x4 v;
                if (e0 < SEQ) v = *(const f32x4*)(ff + e0);
                else { const int d0 = 16384 - e0; const f32x4 a = *(const f32x4*)(fb + d0 - 4); const float bq = d0 < SEQ ? fb[d0] : 0.f; v = (f32x4){bq, a[3], a[2], a[1]}; }
                ssq += (v[0] * v[0] + v[1] * v[1]) + (v[2] * v[2] + v[3] * v[3]);
                f32x2* xp = X + fidx(e0); *(f32x4*)xp = (f32x4){v[0], 0.f, v[1], 0.f}; *(f32x4*)(xp + 2) = (f32x4){v[2], 0.f, v[3], 0.f}; }
        } else {
#pragma unroll 1
            for (int j = 0; j < 2; ++j) { const int t0 = 8 * tid + 4096 * j; float u[2][8];
#pragma unroll
                for (int b = 0; b < 2; ++b) { const bf16* zb = zT + (size_t)(b * 1536 + c) * SEQ; float r1[10], r2[10]; ld10(zb + (size_t)512 * SEQ, t0, r1); ld10(zb + (size_t)1024 * SEQ, t0, r2);
#pragma unroll
                    for (int i = 0; i < 8; ++i) u[b][i] = (w10 * r1[i] + w11 * r1[i + 1] + w12 * r1[i + 2] + b1) * (w20 * r2[i] + w21 * r2[i + 1] + w22 * r2[i + 2] + b2); }
                f32x2* xp = X + fidx(t0);
#pragma unroll
                for (int i = 0; i < 4; ++i) { *(f32x4*)(xp + 2 * i) = (f32x4){u[0][2 * i], u[1][2 * i], u[0][2 * i + 1], u[1][2 * i + 1]}; } }
        }
        __syncthreads();
        if (it == 0) fft_pass16<false, 10>(X, tid); else fft_pass16<false, 10, true>(X, tid);
        __syncthreads();
        fft_pass16<false, 6>(X, tid); __syncthreads();
        fft_pass16<false, 2>(X, tid); __syncthreads();
        if (it == 0) {
#pragma unroll 4
            for (int j = 0; j < 8; ++j) { const int e0 = 4 * tid + 2048 * j; const f32x2* xp = X + fidx(e0);
                const f32x4 v01 = *(const f32x4*)xp, v23 = *(const f32x4*)(xp + 2);
                cf a0 = {v01[0], v01[1]}, a1 = {v01[2], v01[3]}, a2 = {v23[0], v23[1]}, a3 = {v23[2], v23[3]};
                dft4<false>(a0, a1, a2, a3);
                *(f32x4*)(Kfg + e0) = (f32x4){a0.x, a0.y, a1.x, a1.y}; *(f32x4*)(Kfg + e0 + 2) = (f32x4){a2.x, a2.y, a3.x, a3.y}; }
        } else {
#pragma unroll 4
            for (int j = 0; j < 8; ++j) { const int e0 = 4 * tid + 2048 * j; f32x2* xp = X + fidx(e0);
                const f32x4 k01 = *(const f32x4*)(Kfg + e0), k23 = *(const f32x4*)(Kfg + e0 + 2); const f32x4 v01 = *(const f32x4*)xp, v23 = *(const f32x4*)(xp + 2);
                cf a0 = {v01[0], v01[1]}, a1 = {v01[2], v01[3]}, a2 = {v23[0], v23[1]}, a3 = {v23[2], v23[3]};
                dft4<false>(a0, a1, a2, a3);
                a0 = cmul(a0, {k01[0], k01[1]}); a1 = cmul(a1, {k01[2], k01[3]}); a2 = cmul(a2, {k23[0], k23[1]}); a3 = cmul(a3, {k23[2], k23[3]});
                dft4<true>(a0, a1, a2, a3);
                *(f32x4*)xp = (f32x4){a0.x, a0.y, a1.x, a1.y}; *(f32x4*)(xp + 2) = (f32x4){a2.x, a2.y, a3.x, a3.y}; }
        }
        __syncthreads();
    }
    fft_pass16<true, 2>(X, tid); __syncthreads();
    fft_pass16<true, 6>(X, tid); __syncthreads();
    fft_pass16<true, 10, true>(X, tid); __syncthreads();
    const float tot = block_sum(ssq, red, lane, wid);
    const float scale = rsqrtf(tot) * (1.f / 16384.f);
    const bf16* gbT = (const bf16*)(ws + WS_GBT); bf16* gated = (bf16*)(ws + WS_GATED) + 512;
#pragma unroll 1
    for (int j = 0; j < 2; ++j) { const int t0 = 8 * tid + 4096 * j; const f32x2* xp = X + fidx(t0);
        float y[2][8];
#pragma unroll
        for (int i = 0; i < 4; ++i) { const f32x4 v = *(const f32x4*)(xp + 2 * i); y[0][2 * i] = v[0]; y[1][2 * i] = v[1]; y[0][2 * i + 1] = v[2]; y[1][2 * i + 1] = v[3]; }
#pragma unroll
        for (int b = 0; b < 2; ++b) { const bf16* zb = zT + (size_t)(b * 1536 + c) * SEQ; float r0[10], r1[10], r2[10]; ld10(zb, t0, r0); ld10(zb + (size_t)512 * SEQ, t0, r1); ld10(zb + (size_t)1024 * SEQ, t0, r2);
            const u32x4 graw = *(const u32x4*)(gbT + (size_t)(b * 512 + c) * SEQ + t0);
            float g[8]; g[0] = bf2f(graw.x & 0xffffu); g[1] = bf2f(graw.x >> 16); g[2] = bf2f(graw.y & 0xffffu); g[3] = bf2f(graw.y >> 16); g[4] = bf2f(graw.z & 0xffffu); g[5] = bf2f(graw.z >> 16); g[6] = bf2f(graw.w & 0xffffu); g[7] = bf2f(graw.w >> 16);
            bf16* gp = gated + ((size_t)b * SEQ + t0) * 1536 + c;
#pragma unroll
            for (int i = 0; i < 8; ++i) { const float x0 = w00 * r0[i] + w01 * r0[i + 1] + w02 * r0[i + 2] + b0; const float uu = (w10 * r1[i] + w11 * r1[i + 1] + w12 * r1[i + 2] + b1) * (w20 * r2[i] + w21 * r2[i + 1] + w22 * r2[i + 2] + b2);
                gp[(size_t)i * 1536] = f2bf(x0 * (y[b][i] * scale + hbias * uu) * g[i]); } } }
    __syncthreads();
}
__device__ __forceinline__ void hyena_ctx_pair(const Params& p, int l, int item0, unsigned char* lds, int wid0) {
    MK_TIDS(wid0)
    unsigned char* ws = p.ws;
    const int hsel = tid >> 8, t = tid & 255, item = item0 + hsel, b = item >> 9, c = item & 511;
    float* us = (float*)lds + hsel * 1024; float* kf = us + 256; float* kb = kf + 256; float* red = (float*)lds + 2048;
    const float* filt = (const float*)(ws + WS_FILTC) + (size_t)l * 262144;
    const float* sw = p.in[I_SW] + l * 3 * 1536; const float* sb = p.in[I_SB] + l * 1536;
    const bf16* z0 = (const bf16*)(ws + WS_ZHYTC) + (size_t)(b * 1536 + c) * CTXL;
    const float x0 = sconv(z0, t, CTXL, sw[c], sw[1536 + c], sw[3072 + c], sb[c]);
    const float x1 = sconv(z0 + 512 * CTXL, t, CTXL, sw[512 + c], sw[1536 + 512 + c], sw[3072 + 512 + c], sb[512 + c]);
    const float vv = sconv(z0 + 1024 * CTXL, t, CTXL, sw[1024 + c], sw[1536 + 1024 + c], sw[3072 + 1024 + c], sb[1024 + c]);
    const float uu = x1 * vv; const float fa = filt[(size_t)c * CTXL + t], fb = filt[(size_t)(512 + c) * CTXL + t];
    const float g = bf2f(((const bf16*)(ws + WS_GBTC))[(size_t)(b * 512 + c) * CTXL + t]); const float hb = p.in[I_HBIAS][l * 512 + c];
    us[t] = uu; kf[t] = fa; kb[t] = fb;
    const float ssq = wave_sum(fa * fa + (t >= 1 ? fb * fb : 0.f));
    if (lane == 0) red[wid] = ssq;
    __syncthreads();
    const float tot = (red[4 * hsel] + red[4 * hsel + 1]) + (red[4 * hsel + 2] + red[4 * hsel + 3]);
    float acc0 = 0.f, acc1 = 0.f;
#pragma unroll 8
    for (int s = 0; s < 256; s += 2) { acc0 += (s <= t ? kf[t - s] : kb[s - t]) * us[s]; acc1 += (s + 1 <= t ? kf[t - s - 1] : kb[s + 1 - t]) * us[s + 1]; }
    const float y = (acc0 + acc1) * rsqrtf(tot);
    bf16* gated = (bf16*)(ws + WS_GATED) + 512;
    gated[((size_t)MLAT + b * CTXL + t) * 1536 + c] = f2bf(x0 * (y + hb * uu) * g);
    __syncthreads();
}
__device__ __forceinline__ void gmlp_item(const Params& p, int l, int row0, int hf, unsigned char* lds, int wid0) {
    MK_TIDS(wid0)
    unsigned char* ws = p.ws;
    bf16* vT = (bf16*)lds;
    const bf16* zgm = (const bf16*)(ws + WS_ZGM); const bf16* gc = (const bf16*)(ws + WS_GC); bf16* gated = (bf16*)(ws + WS_GATED) + 1024;
    const float* lg = p.in[I_LNG] + l * 512 + 8 * lane; const float* lb = p.in[I_LNB] + l * 512 + 8 * lane;
    float g8[8], b8[8];
#pragma unroll
    for (int i = 0; i < 8; ++i) { g8[i] = lg[i]; b8[i] = lb[i]; }
#pragma unroll 1
    for (int hb = 0; hb < 2; ++hb) {
        u32x4 raw[8];
#pragma unroll
        for (int rr = 0; rr < 8; ++rr) raw[rr] = *(const u32x4*)(zgm + (size_t)(row0 + wid * 16 + hb * 8 + rr) * 1024 + 512 + 8 * lane);
        float v[8][8], s[8];
#pragma unroll
        for (int rr = 0; rr < 8; ++rr) { v[rr][0] = bf2f(raw[rr].x & 0xffffu); v[rr][1] = bf2f(raw[rr].x >> 16); v[rr][2] = bf2f(raw[rr].y & 0xffffu); v[rr][3] = bf2f(raw[rr].y >> 16); v[rr][4] = bf2f(raw[rr].z & 0xffffu); v[rr][5] = bf2f(raw[rr].z >> 16); v[rr][6] = bf2f(raw[rr].w & 0xffffu); v[rr][7] = bf2f(raw[rr].w >> 16);
            s[rr] = ((v[rr][0] + v[rr][1]) + (v[rr][2] + v[rr][3])) + ((v[rr][4] + v[rr][5]) + (v[rr][6] + v[rr][7])); }
#pragma unroll
        for (int rr = 0; rr < 8; ++rr) s[rr] = wave_sum(s[rr]) * (1.f / 512.f);
#pragma unroll
        for (int rr = 0; rr < 8; ++rr) { float q = 0.f;
#pragma unroll
            for (int i = 0; i < 8; ++i) { v[rr][i] -= s[rr]; q += v[rr][i] * v[rr][i]; }
            s[rr] = q; }
#pragma unroll
        for (int rr = 0; rr < 8; ++rr) s[rr] = rsqrtf(wave_sum(s[rr]) * (1.f / 512.f) + EPSN);
        if ((lane >> 5) == hf) {
#pragma unroll
            for (int rr = 0; rr < 8; ++rr) { const int q = wid * 16 + hb * 8 + rr;
#pragma unroll
                for (int i = 0; i < 8; ++i) vT[(8 * (lane & 31) + i) * 136 + q] = f2bf(v[rr][i] * s[rr] * g8[i] + b8[i]); } }
    }
    __syncthreads();
    const int r32 = lane & 31, hi = lane >> 5;
#pragma unroll 1
    for (int bi = 0; bi < 4; ++bi) { const int blk = wid + 8 * bi, gi = blk >> 3, pb = (blk >> 1) & 3, db = blk & 1; const int g = 4 * hf + gi;
        const float* wsrc = p.in[I_GWS] + ((size_t)(l * 8 + g) * 128 + 32 * pb + r32) * 128 + 8 * hi;
        const int ch = 256 * hf + 64 * gi + 32 * db + r32;
        float bsv[16]; bf16 uu[16], gg[16];
#pragma unroll
        for (int r = 0; r < 16; ++r) { const int pp = 32 * pb + crow(r, hi); const size_t row = (size_t)row0 + pp; bsv[r] = p.in[I_GBS][(l * 8 + g) * 128 + pp]; uu[r] = zgm[row * 1024 + ch]; gg[r] = gc[row * 512 + ch]; }
        f32x4 a0[8], a1[8];
#pragma unroll
        for (int ks = 0; ks < 8; ++ks) { a0[ks] = *(const f32x4*)(wsrc + 16 * ks); a1[ks] = *(const f32x4*)(wsrc + 16 * ks + 4); }
        f32x16 acc;
#pragma unroll
        for (int r = 0; r < 16; ++r) acc[r] = 0.f;
#pragma unroll
        for (int ks = 0; ks < 8; ++ks) {
            u32x4 aw; aw.x = pg8::cvt_pk_bf16(a0[ks][0], a0[ks][1]); aw.y = pg8::cvt_pk_bf16(a0[ks][2], a0[ks][3]); aw.z = pg8::cvt_pk_bf16(a1[ks][0], a1[ks][1]); aw.w = pg8::cvt_pk_bf16(a1[ks][2], a1[ks][3]);
            const bf16x8 bfr = *(const bf16x8*)(vT + (64 * gi + 32 * db + r32) * 136 + 16 * ks + 8 * hi);
            acc = __builtin_amdgcn_mfma_f32_32x32x16_bf16(__builtin_bit_cast(bf16x8, aw), bfr, acc, 0, 0, 0); }
#pragma unroll
        for (int r = 0; r < 16; ++r) { const int pp = 32 * pb + crow(r, hi); const size_t row = (size_t)row0 + pp;
            gated[row * 1536 + ch] = f2bf(bf2f(uu[r]) * (acc[r] + bsv[r]) * bf2f(gg[r])); } }
    __syncthreads();
}
template <bool MERGE> __device__ __forceinline__ void ctx_mini_gemm(const Params& p, unsigned char* lds, int wid0) {
    MK_TIDS(wid0)
    unsigned char* ws = p.ws;
    const int r32 = lane & 31, hi = lane >> 5;
    float* part = (float*)lds;
    for (int tile = blockIdx.x; tile < 256; tile += gridDim.x) {
        const int rb = tile >> 4, cb = tile & 15; const size_t arow = (size_t)MLAT + 32 * rb + r32;
        f32x16 tot[2];
#pragma unroll
        for (int c2 = 0; c2 < 2; ++c2)
#pragma unroll
            for (int r = 0; r < 16; ++r) tot[c2][r] = 0.f;
        if (MERGE) {
            const bf16* A = (const bf16*)(ws + WS_GATED) + arow * 1536 + 64 * wid + 8 * hi; const bf16* B = (const bf16*)(ws + WS_WBR) + (size_t)(64 * cb + r32) * 1536 + 64 * wid + 8 * hi;
            const bf16* sel = (const bf16*)(ws + WS_SEL);
#pragma unroll
            for (int i = 0; i < 3; ++i) { f32x16 acc[2];
#pragma unroll
                for (int c2 = 0; c2 < 2; ++c2)
#pragma unroll
                    for (int r = 0; r < 16; ++r) acc[c2][r] = 0.f;
#pragma unroll
                for (int ks = 0; ks < 4; ++ks) { const bf16x8 a = *(const bf16x8*)(A + i * 512 + 16 * ks), b0 = *(const bf16x8*)(B + i * 512 + 16 * ks), b1 = *(const bf16x8*)(B + (size_t)32 * 1536 + i * 512 + 16 * ks);
                    acc[0] = __builtin_amdgcn_mfma_f32_32x32x16_bf16(a, b0, acc[0], 0, 0, 0); acc[1] = __builtin_amdgcn_mfma_f32_32x32x16_bf16(a, b1, acc[1], 0, 0, 0); }
#pragma unroll
                for (int c2 = 0; c2 < 2; ++c2)
#pragma unroll
                    for (int r = 0; r < 16; ++r) tot[c2][r] += acc[c2][r] * bf2f(sel[((size_t)MLAT + 32 * rb + crow(r, hi)) * 3072 + i * 1024 + 64 * cb + 32 * c2 + r32]); }
        } else {
            const bf16* A = (const bf16*)(ws + WS_OUTPRE) + arow * 1024 + 128 * wid + 8 * hi; const bf16* B = (const bf16*)(ws + WS_WOUT) + (size_t)(64 * cb + r32) * 1024 + 128 * wid + 8 * hi;
#pragma unroll
            for (int ks = 0; ks < 8; ++ks) { const bf16x8 a = *(const bf16x8*)(A + 16 * ks), b0 = *(const bf16x8*)(B + 16 * ks), b1 = *(const bf16x8*)(B + (size_t)32 * 1024 + 16 * ks);
                tot[0] = __builtin_amdgcn_mfma_f32_32x32x16_bf16(a, b0, tot[0], 0, 0, 0); tot[1] = __builtin_amdgcn_mfma_f32_32x32x16_bf16(a, b1, tot[1], 0, 0, 0); }
        }
#pragma unroll
        for (int c2 = 0; c2 < 2; ++c2)
#pragma unroll
            for (int r = 0; r < 16; ++r) part[(wid * 32 + crow(r, hi)) * 64 + 32 * c2 + r32] = tot[c2][r];
        __syncthreads();
        { const int e = 4 * tid, rr = e >> 6, cc = e & 63; f32x4 sum = *(const f32x4*)(part + e);
#pragma unroll
          for (int w = 1; w < 8; ++w) sum = sum + *(const f32x4*)(part + w * 2048 + e);
          const size_t row = (size_t)MLAT + 32 * rb + rr; const int col = 64 * cb + cc;
          if (MERGE) { u32x2 o; o.x = pg8::cvt_pk_bf16(sum[0], sum[1]); o.y = pg8::cvt_pk_bf16(sum[2], sum[3]); *(u32x2*)((bf16*)(ws + WS_OUTPRE) + row * 1024 + col) = o; }
          else { u32x2 o; o.x = pg8::cvt_pk_bf16(sum[0], sum[1]); o.y = pg8::cvt_pk_bf16(sum[2], sum[3]); *(u32x2*)((bf16*)(ws + WS_OUT) + row * 1024 + col) = o; } }
        __syncthreads();
    }
}
#define XB_TMO      128
#define XB_XCNT(j)  (256  + 64 * (j))
#define XB_XSUB(j)  (1280 + 64 * (j))
#define XB_XGEN(j)  (2304 + 64 * (j))
#define XB_TOP      3328
#define XB_TOPGEN   3392
#define XCD_BAR_WORDS 3456
#define XB_SPIN_CAP (1u << 18)

__device__ __forceinline__ unsigned xb_ld(unsigned* p)              { return __hip_atomic_load(p, __ATOMIC_RELAXED, __HIP_MEMORY_SCOPE_AGENT); }
__device__ __forceinline__ unsigned xb_add(unsigned* p, unsigned v) { return __hip_atomic_fetch_add(p, v, __ATOMIC_RELAXED, __HIP_MEMORY_SCOPE_AGENT); }
__device__ __forceinline__ unsigned xb_xcc_id() { return (unsigned)__builtin_amdgcn_s_getreg((3 << 11) | 20) & 0xFu; }
#define XB_SPIN(cond, bar) do { unsigned _sp = 0; while (cond) { __builtin_amdgcn_s_sleep(1); \
    if ((++_sp & 255u) == 0u) { if (xb_ld(&(bar)[XB_TMO])) break; if (_sp > XB_SPIN_CAP) { atomicAdd(&(bar)[XB_TMO], 1u); break; } } } } while (0)

struct XcdBarrier {
    unsigned* bar; unsigned x;
    volatile LAS unsigned* st;
};

__device__ __forceinline__ XcdBarrier xcd_barrier_post(unsigned* bar, volatile LAS unsigned* st) {
    XcdBarrier b; b.bar = bar; b.x = xb_xcc_id(); b.st = st;
    if (threadIdx.x == 0) (void)xb_add(&bar[XB_XCNT(b.x)], 1u);
    return b;
}
__device__ __forceinline__ void xcd_barrier_complete(unsigned* bar, unsigned x, unsigned& nloc, unsigned& nx) {
    const unsigned G = gridDim.x * gridDim.y * gridDim.z;
    unsigned sum, cnt, mine, sp = 0u;
    for (;;) {
        sum = 0u; cnt = 0u; mine = 0u;
#pragma unroll
        for (unsigned j = 0; j < 16; ++j) { const unsigned c = xb_ld(&bar[XB_XCNT(j)]); sum += c; cnt += (c > 0u) ? 1u : 0u; mine = (j == x) ? c : mine; }
        if (sum == G) break;
        __builtin_amdgcn_s_sleep(1);
        if ((++sp & 255u) == 0u) { if (xb_ld(&bar[XB_TMO])) break; if (sp > XB_SPIN_CAP) { atomicAdd(&bar[XB_TMO], 1u); break; } }
    }
    nloc = mine > 0u ? mine : 1u; nx = cnt > 0u ? cnt : 1u;
}

__device__ __forceinline__ void xcd_barrier(const XcdBarrier& b) {
    asm volatile("s_waitcnt vmcnt(0)" ::: "memory");
    __syncthreads();
    if (threadIdx.x == 0) {
        unsigned* bar = b.bar;
        __builtin_amdgcn_s_waitcnt(0);
        unsigned nloc = b.st[0], nx = b.st[1];
        if (nloc == 0u) { xcd_barrier_complete(bar, b.x, nloc, nx); b.st[0] = nloc; b.st[1] = nx; }
        const unsigned old = xb_add(&bar[XB_XSUB(b.x)], 1u);
        const unsigned gen = old / nloc;
        if (old + 1u == (gen + 1u) * nloc) {
            __builtin_amdgcn_fence(__ATOMIC_RELEASE, "agent");
            asm volatile("s_waitcnt vmcnt(0)" ::: "memory");
            const unsigned og = xb_add(&bar[XB_TOP], 1u);
            const unsigned tg = og / nx;
            if (og + 1u == (tg + 1u) * nx) xb_add(&bar[XB_TOPGEN], 1u);
            else XB_SPIN(xb_ld(&bar[XB_TOPGEN]) == tg, bar);
            __builtin_amdgcn_fence(__ATOMIC_ACQUIRE, "agent");
            xb_add(&bar[XB_XGEN(b.x)], 1u);
            asm volatile("s_waitcnt vmcnt(0)" ::: "memory");
        } else {
            XB_SPIN(xb_ld(&bar[XB_XGEN(b.x)]) == gen, bar);
            __builtin_amdgcn_fence(__ATOMIC_ACQUIRE, "agent");
            asm volatile("s_waitcnt vmcnt(0)" ::: "memory");
        }
    }
    __syncthreads();
}

__device__ __forceinline__ void phaseC(const Params& p, int l, unsigned char* lds, int wid0) {
    int lane; asm volatile("v_mbcnt_lo_u32_b32 %0, -1, 0\n\tv_mbcnt_hi_u32_b32 %0, -1, %0" : "=v"(lane));
    const bool last = (l == DEPTH - 1);
    const float lam_init = 0.8f - 0.6f * expf(-0.3f * (float)l);
    float lam;
    { const float* lp = p.in[I_LAM] + l * 256; const float s1 = wave_sum(lp[lane] * lp[64 + lane]), s2 = wave_sum(lp[128 + lane] * lp[192 + lane]); lam = expf(s1) - expf(s2) + lam_init; }
    const int G = gridDim.x, bx = blockIdx.x;
#ifndef NO_ATT
    for (int rep = 0; rep < REP_ATT; ++rep)
    { const int nun = last ? 64 : 66;
      const int xg = (G % 8 == 0) ? 8 : 1, xi = bx % xg, ji = bx / xg, jn = G / xg;
      for (int bh = xi; bh < 8; bh += xg)
        for (int qb = ji; qb < nun; qb += jn) {
            const int b = bh >> 2, h = bh & 3; int qpos0, kbeg, nkt, grow0;
            if (qb < 64) { qpos0 = qb * 128; kbeg = 0; nkt = KEYS / 64; grow0 = b * SEQ + qb * 128; }
            else { qpos0 = SEQ + (qb - 64) * 128; kbeg = SEQ; nkt = CTXL / 64; grow0 = MLAT + b * CTXL + (qb - 64) * 128; }
            attn_unit(p, l, b, h, qpos0, kbeg, nkt, grow0, lam, lam_init, lds, wid0); } }
#endif
#ifndef NO_HY
    for (int rep = 0; rep < REP_HY; ++rep)
    for (int k = bx; k < 512; k += G) { const int c = (G == 256) ? (64 * (k & 7) + 32 * (k >> 8) + ((k & 255) >> 3)) : k;     hyena_channel(p, l, c, lds, wid0); }
#endif
#ifndef NO_HYC
    if (!last) for (int k = bx; k < 512; k += G) { const int it = (G == 256) ? ((k & 256) + 32 * (k & 7) + (((k & 255) >> 3) & 15) + 16 * ((k & 255) >> 7)) : k; hyena_ctx_pair(p, l, 2 * it, lds, wid0); }
#endif
#ifndef NO_GM
    for (int rep = 0; rep < REP_GM; ++rep)
    for (int it = bx; it < 256; it += G) gmlp_item(p, l, (it >> 1) * 128, it & 1, lds, wid0);
    if (!last) for (int it = (bx >= 128 ? bx - 128 : bx + G - 128); it < 8; it += G) gmlp_item(p, l, MLAT + (it >> 1) * 128, it & 1, lds, wid0);
#endif
}
__device__ __forceinline__ void phaseB(const Params& p, int l, unsigned char* lds, int wid0) {
    unsigned char* ws = p.ws;
    pg8::Gemm g{(const bf16*)(ws + WS_H), (const bf16*)(ws + WS_WIN), MROWS, NCOL, 1024}; pg8::StaticOrder S; S.init(MROWS, NCOL, gridDim.x, blockIdx.x);
    EpiIn E; E.K = (bf16*)(ws + WS_K); E.Q = (bf16*)(ws + WS_Q); E.Vt = (bf16*)(ws + WS_VT); E.ga = (bf16*)(ws + WS_GA); E.gc = (bf16*)(ws + WS_GC); E.zgm = (bf16*)(ws + WS_ZGM); E.sel = (bf16*)(ws + WS_SEL);
    E.zhyT = (bf16*)(ws + WS_ZHYT); E.zhyTc = (bf16*)(ws + WS_ZHYTC); E.gbT = (bf16*)(ws + WS_GBT); E.gbTc = (bf16*)(ws + WS_GBTC); E.rope = (const float*)(ws + WS_ROPE); E.kmax = (unsigned*)(ws + WS_CTL) + l * 32; E.last = (l == DEPTH - 1);
    pg8::gemm_phase<EpiIn, pg8::StaticOrder, true, true>((PG8_LAS unsigned char*)lds, g, S, E, mk_tid(wid0));
}
__device__ __forceinline__ void phaseD(const Params& p, int l, unsigned char* lds, int wid0) {
    unsigned char* ws = p.ws; const int M = MLAT;
    pg8::StaticOrder S; S.init(M, 1024, gridDim.x, blockIdx.x);
    pg8::Gemm g{(const bf16*)(ws + WS_GATED), (const bf16*)(ws + WS_WBR), M, 1024, 1536};
    EpiMergeF E{(const bf16*)(ws + WS_SEL), (bf16*)(ws + WS_OUTPRE)}; MergeHook H{(const bf16*)(ws + WS_SEL)};
    pg8::gemm_phase<EpiMergeF, pg8::StaticOrder, true, true, MergeHook>((PG8_LAS unsigned char*)lds, g, S, E, mk_tid(wid0), H);
    if (l < DEPTH - 1) { __syncthreads(); ctx_mini_gemm<true>(p, lds, wid0); }
}
__device__ __forceinline__ void phaseE(const Params& p, int l, unsigned char* lds, int wid0) {
    unsigned char* ws = p.ws;
    const int M = MLAT;
    pg8::Gemm g{(const bf16*)(ws + WS_OUTPRE), (const bf16*)(ws + WS_WOUT), M, 1024, 1024}; pg8::StaticOrder S; S.init(M, 1024, gridDim.x, blockIdx.x);
    EpiOut E{(bf16*)(ws + WS_OUT), (l == DEPTH - 1)};
    pg8::gemm_phase<EpiOut, pg8::StaticOrder, true, true>((PG8_LAS unsigned char*)lds, g, S, E, mk_tid(wid0));
    if (l < DEPTH - 1) { __syncthreads(); ctx_mini_gemm<false>(p, lds, wid0); }
}

__global__ void __launch_bounds__(512, 2) mk_fwd(Params p) {
    extern __shared__ __attribute__((aligned(16))) unsigned char lds[];
    const int wid0 = __builtin_amdgcn_readfirstlane(threadIdx.x >> 6);
    volatile LAS unsigned* bst = (volatile LAS unsigned*)((LAS unsigned char*)lds + LDS_BYTES - 64);
    if (threadIdx.x < 2) bst[threadIdx.x] = 0u;
    __syncthreads();
    XcdBarrier bar; bar.bar = (unsigned*)(p.ws + WS_BAR); bar.x = 0; bar.st = bst;
    if (p.ph_hi - p.ph_lo > 1) bar = xcd_barrier_post((unsigned*)(p.ws + WS_BAR), bst);
    for (int ph = p.ph_lo; ph < p.ph_hi; ++ph) {
        if (ph == p.ph_lo + 1) cg::this_grid().sync();
        else if (ph > p.ph_lo) for (int rep = 0; rep < REP_SYNC; ++rep) xcd_barrier(bar);
#ifndef NO_0
        if (ph == 0) { phase0(p, wid0); __syncthreads();
            for (int it = blockIdx.x; it < 24; it += gridDim.x) filter_item(p, it >> 3, CTXL, 32 * (it & 7), (float*)(p.ws + WS_FILTC) + (size_t)(it >> 3) * 262144, (float*)(lds + 104448), wid0);
            continue; }
#endif
#ifndef NO_A
        if (ph == NPHASE - 1) { phaseA(p, DEPTH, lds, wid0); continue; }
#endif
        const int l = (ph - 1) / 5, s = (ph - 1) % 5;
#ifndef NO_A
        if (s == 0) phaseA(p, l, lds, wid0);
#endif
#ifndef NO_B
        if (s == 1) for (int rep = 0; rep < REP_B; ++rep) phaseB(p, l, lds, wid0);
#endif
#ifndef NO_C
        if (s == 2) phaseC(p, l, lds, wid0);
#endif
#ifndef NO_D
        if (s == 3) for (int rep = 0; rep < REP_DE; ++rep) phaseD(p, l, lds, wid0);
#endif
#ifndef NO_E
        if (s == 4) for (int rep = 0; rep < REP_DE; ++rep) phaseE(p, l, lds, wid0);
#endif
        __syncthreads();
    }
}

extern "C" void kernel_launch(void* const* d_in, const int* in_sizes, int n_in, void* d_out, int out_size, void* d_ws, size_t ws_size, hipStream_t stream) {
    static int grid = 0;
    if (grid == 0) {
        if (n_in != 26 || out_size != MLAT * DM || ws_size < WS_END) { fprintf(stderr, "kernel_launch: unexpected shapes / workspace (n_in %d out %d ws %zu)\n", n_in, out_size, ws_size); grid = -1; }
        else {
            int dev = 0, cus = 0, per_cu = 0;
            hipGetDevice(&dev); hipDeviceGetAttribute(&cus, hipDeviceAttributeMultiprocessorCount, dev);
            hipFuncSetAttribute((const void*)mk_fwd, hipFuncAttributeMaxDynamicSharedMemorySize, LDS_BYTES);
            hipOccupancyMaxActiveBlocksPerMultiprocessor(&per_cu, (const void*)mk_fwd, 512, LDS_BYTES);
            (void)hipGetLastError();
            if (per_cu < 1) per_cu = 1;
            grid = cus;
        }
    }
    if (grid < 0) { hipMemsetAsync(d_out, 0, (size_t)out_size * 4, stream); return; }
    hipMemsetAsync((char*)d_ws + WS_BAR, 0, XCD_BAR_WORDS * 4, stream);
    Params p{};
    for (int i = 0; i < 26; ++i) p.in[i] = (const float*)d_in[i];
    p.out = (float*)d_out; p.ws = (unsigned char*)d_ws;
#if MK_ONE_LAUNCH
    p.ph_lo = 0; p.ph_hi = NPHASE;
    void* args[] = {&p};
    hipError_t e = hipLaunchCooperativeKernel((const void*)mk_fwd, dim3(grid), dim3(512), args, LDS_BYTES, stream);
    if (e != hipSuccess) fprintf(stderr, "cooperative launch failed: %s (grid %d)\n", hipGetErrorString(e), grid);
#else
    for (int ph = 0; ph < NPHASE; ++ph) { p.ph_lo = ph; p.ph_hi = ph + 1; hipLaunchKernelGGL(mk_fwd, dim3(grid), dim3(512), LDS_BYTES, stream, p); }
#endif
}
```

```cpp
#include <hip/hip_runtime.h>
#include <hip/hip_cooperative_groups.h>
#include <cstdio>
#include <cstdint>
#include <cmath>
namespace cg = cooperative_groups;
namespace pg8 {
#define PG8_LAS __attribute__((address_space(3)))
typedef unsigned short bf16_t;
typedef short bf16x8 __attribute__((ext_vector_type(8)));
typedef float f32x4 __attribute__((ext_vector_type(4)));
typedef unsigned u32x4 __attribute__((ext_vector_type(4)));
constexpr int BM = 256, BK = 64, HALF = 128, HTB = HALF * BK * 2  , STAGE_BYTES = 8 * HTB, NXCD = 8, WGM = 8;

__host__ __device__ __forceinline__ int lds_byte(int r, int c) { const int st = (r >> 4) * 2 + (c >> 5), rr = r & 15, cc = c & 31, ob = rr * 64 + cc * 2; return st * 1024 + (ob ^ (((ob >> 9) & 1) << 5)); }
__host__ __device__ __forceinline__ void stage_rc(int b, int& R, int& C) { const int st = b / 1024, sb = b % 1024, swz = sb ^ (((sb >> 9) & 1) << 5); R = (st >> 1) * 16 + swz / 64; C = (st & 1) * 32 + (swz % 64) / 2; }
__host__ __device__ __forceinline__ int perm32(int rho) { const int n = rho >> 4, i = rho & 15; return 8 * (i >> 2) + 4 * n + (i & 3); }

struct Unit { int pm, pn; };
struct Gemm { const bf16_t* A; const bf16_t* Bt; int M, N, K; };

struct StaticOrder {
    int nM, nN, nwg, G, c;
    __host__ __device__ void init(int M, int N, int G_, int c_) { nM = M / BM; nN = N / BM; nwg = nM * nN; G = G_; c = c_; }
    __host__ __device__ bool next(int i, Unit& u) const {
        const long L = (long)i * G + c; if (L >= nwg) return false;
        int wgid = (int)L; { const int q = nwg / NXCD, r = nwg % NXCD, xcd = wgid % NXCD, off = wgid / NXCD; wgid = (xcd < r ? xcd * (q + 1) : r * (q + 1) + (xcd - r) * q) + off; }
        const int nig = WGM * nN, gid = wgid / nig, fm = gid * WGM, gsz = (nM - fm) < WGM ? (nM - fm) : WGM;
        u.pm = fm + ((wgid % nig) % gsz); u.pn = (wgid % nig) / gsz; return true;
    }
    __device__ __forceinline__ void a_ready(const Unit&) const {}
    __device__ __forceinline__ void done(const Unit&) const {}
};

__device__ __forceinline__ unsigned cvt_pk_bf16(float lo, float hi) { unsigned r; asm volatile("v_cvt_pk_bf16_f32 %0, %1, %2" : "=v"(r) : "v"(lo), "v"(hi)); return r; }
typedef float f32x2 __attribute__((ext_vector_type(2)));
__device__ __forceinline__ f32x2 gelu_pk(f32x2 v) {
    const f32x2 av = __builtin_elementwise_abs(v), d = av * 0.2316418882f + 1.0f;
    f32x2 t; t.x = __builtin_amdgcn_rcpf(d.x); t.y = __builtin_amdgcn_rcpf(d.y);
    f32x2 q = t * 0.5307027145f + (-0.7265760135f); q = q * t + 0.7107068705f; q = q * t + (-0.142248368f); q = q * t + 0.127414796f; q = q * t;
    const f32x2 s = (v * v) * (-0.72134752044f);
    f32x2 e; e.x = __builtin_amdgcn_exp2f(s.x); e.y = __builtin_amdgcn_exp2f(s.y);
    const f32x2 m = v * (q * e), r = v - m;
    f32x2 o; o.x = v.x < 0.f ? m.x : r.x; o.y = v.y < 0.f ? m.y : r.y; return o;
}

struct NoHook { static constexpr bool ON = false; template <class A> __device__ __forceinline__ void operator()(A&, const Unit&, int, int, int, int, int) const {} };
template <class Epi, class Sched, bool ALIGN_EPI = false, bool SP2 = false, class Hook = NoHook>
__device__ __forceinline__ void gemm_phase(PG8_LAS unsigned char* lds, const Gemm g, const Sched& S, const Epi& E, int tid, const Hook& H = Hook()) {
    const int wid = __builtin_amdgcn_readfirstlane(tid >> 6), lane = tid & 63, wr = wid >> 2, wc = wid & 3, fr = lane & 15, fq = lane >> 4;
    const int K = g.K, nt = K / BK;
    unsigned voffA[2], voffB[2];
#pragma unroll
    for (int i = 0; i < 2; ++i) { int R, C; stage_rc(tid * 16 + i * 8192, R, C); const int Rb = Epi::PERM ? ((R & ~31) + perm32(R & 31)) : R;
        voffA[i] = (unsigned)(R * K + C) * 2u; voffB[i] = (unsigned)(Rb * K + C) * 2u; }
    const size_t kstep = (size_t)(BK * 2);
    const size_t hstep = (size_t)HALF * K * 2;
    const size_t tstep = 2 * hstep;
    const unsigned ldsw = (unsigned)wid * 1024u;
    const int aoff = lds_byte(wr * 64 + fr, fq * 8), boff = lds_byte(wc * 32 + fr, fq * 8);
#define PG8_SA(b, h) (((b) * 2 + (h)) * HTB)
#define PG8_SB(b, h) ((4 + (b) * 2 + (h)) * HTB)
#define PG8_STAGE(bufoff, gbase, voff) do { _Pragma("unroll") for (int _i = 0; _i < 2; ++_i) \
        __builtin_amdgcn_global_load_lds((const unsigned*)((const char*)(gbase) + (voff)[_i]), (PG8_LAS unsigned*)(lds + (bufoff) + ldsw + _i * 8192), 16, 0, 0); } while (0)
#define PG8_LDA(dst, b, h) do { _Pragma("unroll") for (int m = 0; m < 4; ++m) _Pragma("unroll") for (int k = 0; k < 2; ++k) dst[m][k] = *(const PG8_LAS bf16x8*)(lds + PG8_SA(b, h) + aoff + m * 2048 + k * 1024); } while (0)
#define PG8_LDB(dst, b, h) do { _Pragma("unroll") for (int n = 0; n < 2; ++n) _Pragma("unroll") for (int k = 0; k < 2; ++k) dst[n][k] = *(const PG8_LAS bf16x8*)(lds + PG8_SB(b, h) + boff + n * 2048 + k * 1024); } while (0)
#define PG8_MMA(ai, bj, At, Bt) do { __builtin_amdgcn_s_setprio(1); _Pragma("unroll") for (int m = 0; m < 4; ++m) _Pragma("unroll") for (int n = 0; n < 2; ++n) _Pragma("unroll") for (int k = 0; k < 2; ++k) \
        acc[ai][bj][m][n] = __builtin_amdgcn_mfma_f32_16x16x32_bf16(Bt[n][k], At[m][k], acc[ai][bj][m][n], 0, 0, 0); __builtin_amdgcn_s_setprio(0); } while (0)
#define PG8_WAIT_V(n) asm volatile("s_waitcnt vmcnt(" #n ")" ::: "memory")
#define PG8_WAIT_L(n) asm volatile("s_waitcnt lgkmcnt(" #n ")" ::: "memory")
#define PG8_BAR __builtin_amdgcn_s_barrier()
#define PG8_SCHED __builtin_amdgcn_sched_barrier(0)
    Unit cur, nxt; int ui = 0;
    if (!S.next(0, cur)) return;
    f32x4 acc[2][2][4][2];
#pragma unroll
    for (int a = 0; a < 2; ++a)
#pragma unroll
        for (int b = 0; b < 2; ++b)
#pragma unroll
            for (int m = 0; m < 4; ++m)
#pragma unroll
                for (int n = 0; n < 2; ++n) acc[a][b][m][n] = (f32x4){0.f, 0.f, 0.f, 0.f};
    bf16x8 At[4][2], B0[2][2], B1[2][2];
    const char* cA = (const char*)g.A + (size_t)cur.pm * tstep; const char* cB = (const char*)g.Bt + (size_t)cur.pn * tstep;
    S.a_ready(cur);
    if constexpr (SP2) {
        PG8_STAGE(PG8_SB(0, 0), cB, voffB); PG8_STAGE(PG8_SB(0, 1), cB + hstep, voffB); PG8_STAGE(PG8_SA(0, 0), cA, voffA); PG8_STAGE(PG8_SA(0, 1), cA + hstep, voffA);
        if (wr == 1) PG8_BAR;
        PG8_WAIT_V(2); PG8_BAR;
        PG8_STAGE(PG8_SB(1, 0), cB + kstep, voffB); PG8_STAGE(PG8_SA(1, 0), cA + kstep, voffA); PG8_STAGE(PG8_SB(1, 1), cB + hstep + kstep, voffB);
        PG8_WAIT_V(6); PG8_BAR;
    } else {
        PG8_STAGE(PG8_SB(0, 0), cB, voffB); PG8_STAGE(PG8_SA(0, 0), cA, voffA); PG8_STAGE(PG8_SB(0, 1), cB + hstep, voffB); PG8_STAGE(PG8_SA(0, 1), cA + hstep, voffA);
        if (wr == 1) PG8_BAR;
        PG8_WAIT_V(4); PG8_BAR;
        PG8_STAGE(PG8_SB(1, 0), cB + kstep, voffB); PG8_STAGE(PG8_SA(1, 0), cA + kstep, voffA); PG8_STAGE(PG8_SB(1, 1), cB + hstep + kstep, voffB);
        PG8_WAIT_V(6); PG8_BAR;
    }
    for (;;) {
        const bool has_next = S.next(ui + 1, nxt);
        const char* nA = has_next ? (const char*)g.A + (size_t)nxt.pm * tstep : cA; const char* nB = has_next ? (const char*)g.Bt + (size_t)nxt.pn * tstep : cB;
        for (int t = 0; t < nt; t += 2) {
            if constexpr (Hook::ON) { if (t == 8 || t == 16) H(acc, cur, wr, wc, fr, fq, t); }
            const bool last = (t == nt - 2);
            const char* a1 = cA + (size_t)(t + 1) * kstep;
            const char* a2 = last ? nA : cA + (size_t)(t + 2) * kstep; const char* b2 = last ? nB : cB + (size_t)(t + 2) * kstep;
            const char* a3 = a2 + kstep; const char* b3 = b2 + kstep;
            if (last && has_next) S.a_ready(nxt);
            if constexpr (SP2) {
            PG8_LDB(B0, 0, 0); PG8_LDB(B1, 0, 1); PG8_SCHED; PG8_LDA(At, 0, 0); PG8_STAGE(PG8_SA(1, 1), a1 + hstep, voffA);
            PG8_WAIT_V(8); PG8_WAIT_L(0); PG8_BAR; PG8_MMA(0, 0, At, B0); PG8_MMA(0, 1, At, B1); PG8_BAR; PG8_SCHED;
            PG8_LDA(At, 0, 1); PG8_STAGE(PG8_SB(0, 0), b2, voffB); PG8_STAGE(PG8_SB(0, 1), b2 + hstep, voffB); PG8_STAGE(PG8_SA(0, 0), a2, voffA);
            PG8_WAIT_V(8); PG8_WAIT_L(0); PG8_BAR; PG8_MMA(1, 0, At, B0); PG8_MMA(1, 1, At, B1); PG8_BAR; PG8_SCHED;
            PG8_LDB(B0, 1, 0); PG8_LDB(B1, 1, 1); PG8_SCHED; PG8_LDA(At, 1, 0); PG8_STAGE(PG8_SA(0, 1), a2 + hstep, voffA);
            PG8_WAIT_V(8); PG8_WAIT_L(0); PG8_BAR; PG8_MMA(0, 0, At, B0); PG8_MMA(0, 1, At, B1); PG8_BAR; PG8_SCHED;
            PG8_LDA(At, 1, 1); PG8_STAGE(PG8_SB(1, 0), b3, voffB); PG8_STAGE(PG8_SB(1, 1), b3 + hstep, voffB); PG8_STAGE(PG8_SA(1, 0), a3, voffA);
            PG8_WAIT_V(8); PG8_WAIT_L(0); PG8_BAR; PG8_MMA(1, 0, At, B0); PG8_MMA(1, 1, At, B1); PG8_BAR; PG8_SCHED;
            } else {
            PG8_LDB(B0, 0, 0); PG8_SCHED; PG8_LDA(At, 0, 0); PG8_STAGE(PG8_SA(1, 1), a1 + hstep, voffA);
            PG8_WAIT_L(8); PG8_BAR; PG8_WAIT_L(0); PG8_MMA(0, 0, At, B0); PG8_BAR; PG8_SCHED;
            PG8_LDB(B1, 0, 1); PG8_STAGE(PG8_SB(0, 0), b2, voffB);
            PG8_BAR; PG8_WAIT_L(0); PG8_MMA(0, 1, At, B1); PG8_BAR;
            PG8_LDA(At, 0, 1); PG8_STAGE(PG8_SA(0, 0), a2, voffA);
            PG8_BAR; PG8_WAIT_L(0); PG8_MMA(1, 0, At, B0); PG8_BAR; PG8_SCHED;
            PG8_STAGE(PG8_SB(0, 1), b2 + hstep, voffB);
            PG8_WAIT_V(6); PG8_BAR; PG8_MMA(1, 1, At, B1); PG8_BAR;
            PG8_LDB(B0, 1, 0); PG8_SCHED; PG8_LDA(At, 1, 0); PG8_STAGE(PG8_SA(0, 1), a2 + hstep, voffA);
            PG8_WAIT_L(8); PG8_BAR; PG8_WAIT_L(0); PG8_MMA(0, 0, At, B0); PG8_BAR; PG8_SCHED;
            PG8_LDB(B1, 1, 1); PG8_STAGE(PG8_SB(1, 0), b3, voffB);
            PG8_BAR; PG8_WAIT_L(0); PG8_MMA(0, 1, At, B1); PG8_BAR;
            PG8_LDA(At, 1, 1); PG8_STAGE(PG8_SA(1, 0), a3, voffA);
            PG8_BAR; PG8_WAIT_L(0); PG8_MMA(1, 0, At, B0); PG8_BAR; PG8_SCHED;
            PG8_STAGE(PG8_SB(1, 1), b3 + hstep, voffB);
            PG8_WAIT_V(6); PG8_BAR; PG8_MMA(1, 1, At, B1); PG8_BAR;
            }
        }
        if constexpr (ALIGN_EPI) { if (wr == 0) PG8_BAR; }
        if constexpr (!Epi::AFTER_DRAIN) { E(acc, cur, wr, wc, fr, fq); S.done(cur); }
        if (!has_next) break;
#pragma unroll
        for (int a = 0; a < 2; ++a)
#pragma unroll
            for (int b = 0; b < 2; ++b)
#pragma unroll
                for (int m = 0; m < 4; ++m)
#pragma unroll
                    for (int n = 0; n < 2; ++n) acc[a][b][m][n] = (f32x4){0.f, 0.f, 0.f, 0.f};
        cur = nxt; cA = nA; cB = nB; ++ui;
        if constexpr (ALIGN_EPI) { if (wr == 1) PG8_BAR; }
    }
    PG8_WAIT_V(0);
    if constexpr (!ALIGN_EPI) { if (wr == 0) PG8_BAR; }
    PG8_BAR;
    if constexpr (Epi::AFTER_DRAIN) { E.fused(acc, cur, wr, wc, fr, fq, lds, wid, lane); S.done(cur); }
#undef PG8_SA
#undef PG8_SB
#undef PG8_STAGE
#undef PG8_LDA
#undef PG8_LDB
#undef PG8_MMA
#undef PG8_WAIT_V
#undef PG8_WAIT_L
#undef PG8_BAR
#undef PG8_SCHED
}
}
#ifndef REP_B
#define REP_B 1
#endif
#ifndef REP_ATT
#define REP_ATT 1
#endif
#ifndef REP_HY
#define REP_HY 1
#endif
#ifndef REP_GM
#define REP_GM 1
#endif
#ifndef REP_DE
#define REP_DE 1
#endif
#ifndef REP_A2
#define REP_A2 1
#endif
#ifndef REP_SYNC
#define REP_SYNC 1
#endif
#ifndef MK_ONE_LAUNCH
#define MK_ONE_LAUNCH 1
#endif
#define LAS __attribute__((address_space(3)))
typedef unsigned short bf16;
typedef float f32x4 __attribute__((ext_vector_type(4)));
typedef float f32x2 __attribute__((ext_vector_type(2)));
typedef float f32x16 __attribute__((ext_vector_type(16)));
typedef short bf16x8 __attribute__((ext_vector_type(8)));
typedef unsigned u32x2 __attribute__((ext_vector_type(2)));
typedef unsigned u32x4 __attribute__((ext_vector_type(4)));

constexpr int DM = 1024, SEQ = 8192, CTXL = 256, MROWS = 16896, MLAT = 16384, NCOL = 8704, KEYS = 8448, DEPTH = 4;
constexpr float EPSN = 1e-6f;
constexpr float QSCALE = 0.125f * 1.4426950408889634f;
constexpr size_t MiB = 1u << 20;
constexpr size_t WS_CTL = 0, WS_BAR = 65536, WS_MODP = 1 * MiB, WS_ROPE = 3 * MiB, WS_XC = 4 * MiB, WS_WIN = 8 * MiB, WS_WBR = 25 * MiB, WS_WOUT = 28 * MiB,
    WS_H = 32 * MiB, WS_K = 66 * MiB, WS_Q = 83 * MiB, WS_VT = 100 * MiB, WS_GA = 117 * MiB, WS_GC = 134 * MiB, WS_ZGM = 151 * MiB, WS_SEL = 184 * MiB,
    WS_ZHYT = 283 * MiB, WS_ZHYTC = 331 * MiB, WS_GBT = 333 * MiB, WS_GBTC = 349 * MiB, WS_GATED = 350 * MiB, WS_FILT = 400 * MiB, WS_FILTC = 432 * MiB  , WS_END = 436 * MiB;
constexpr size_t WS_OUTPRE = WS_H, WS_OUT = WS_SEL, WS_TMP = WS_ZHYT;
constexpr size_t GATED_STRIDE = (size_t)MROWS * 512;
constexpr int LDS_BYTES = 147456;
constexpr int NPHASE = 22;

struct Params { const float* in[26]; float* out; unsigned char* ws; int ph_lo, ph_hi; };
enum { I_X = 0, I_C, I_CTX, I_CCTX, I_ADAW, I_ADAB, I_NPRE, I_NPOST, I_WIN, I_LAM, I_SUBLN, I_SW, I_SB, I_FW1, I_FB1, I_FW2, I_FB2, I_FW3, I_FFREQ, I_HBIAS, I_LNG, I_LNB, I_GWS, I_GBS, I_WBR, I_WOUT };

#define MK_TIDS(w0) int tid; asm volatile("v_mbcnt_lo_u32_b32 %0, -1, 0\n\tv_mbcnt_hi_u32_b32 %0, -1, %0" : "=v"(tid)); const int lane = tid; tid += (w0) * 64; const int wid = (w0);
__device__ __forceinline__ int mk_tid(int w0) { int t; asm volatile("v_mbcnt_lo_u32_b32 %0, -1, 0\n\tv_mbcnt_hi_u32_b32 %0, -1, %0" : "=v"(t)); return t + w0 * 64; }
__device__ __forceinline__ float bf2f(unsigned b) { return __uint_as_float(b << 16); }
__device__ __forceinline__ bf16 f2bf(float v) { return (bf16)(pg8::cvt_pk_bf16(v, 0.f) & 0xffffu); }
__device__ __forceinline__ float wave_sum(float v) {
#pragma unroll
    for (int o = 1; o < 64; o <<= 1) v += __shfl_xor(v, o);
    return v;
}
__device__ __forceinline__ float silu_f(float x) { return x * __builtin_amdgcn_rcpf(1.f + __expf(-x)); }
__device__ __forceinline__ float sigm_f(float x) { return __builtin_amdgcn_rcpf(1.f + __expf(-x)); }
__device__ __forceinline__ int crow(int r, int hi) { return (r & 3) + 8 * (r >> 2) + 4 * hi; }

struct EpiIn {
    static constexpr bool PERM = false, AFTER_DRAIN = false;
    bf16 *K, *Q, *Vt, *ga, *gc, *zgm, *sel, *zhyT, *zhyTc, *gbT, *gbTc; const float* rope; unsigned* kmax; int last;
    template <int ACT> __device__ __forceinline__ static float act(float v) { if (ACT == 1) return silu_f(v); if (ACT == 3) return sigm_f(v); return v; }
    template <int ACT> __device__ __forceinline__ void rowmajor(const f32x4 (&acc)[2][2][4][2], bf16* dst, int ld, int colbase, int row0, int wc, int fq) const {
#pragma unroll
        for (int ai = 0; ai < 2; ++ai)
#pragma unroll
            for (int m = 0; m < 4; ++m) { bf16* rowp = dst + (size_t)(row0 + ai * 128 + m * 16) * ld + colbase + wc * 32 + 4 * fq;
#pragma unroll
                for (int bj = 0; bj < 2; ++bj)
#pragma unroll
                    for (int n = 0; n < 2; ++n) { f32x4 v = acc[ai][bj][m][n];
                        if (ACT == 2) { f32x2 a = pg8::gelu_pk((f32x2){v[0], v[1]}), b = pg8::gelu_pk((f32x2){v[2], v[3]}); v = (f32x4){a.x, a.y, b.x, b.y}; }
                        else { v[0] = act<ACT>(v[0]); v[1] = act<ACT>(v[1]); v[2] = act<ACT>(v[2]); v[3] = act<ACT>(v[3]); }
                        u32x2 w; w.x = pg8::cvt_pk_bf16(v[0], v[1]); w.y = pg8::cvt_pk_bf16(v[2], v[3]); *(u32x2*)(rowp + bj * 128 + n * 16) = w; } }
    }
    template <int ACT> __device__ __forceinline__ void transposed(const f32x4 (&acc)[2][2][4][2], bf16* dstT, int LT, int colbase, int t0, int wc, int fq) const {
#pragma unroll
        for (int ai = 0; ai < 2; ++ai)
#pragma unroll
            for (int m = 0; m < 4; ++m) { const int t = t0 + ai * 128 + m * 16;
#pragma unroll
                for (int bj = 0; bj < 2; ++bj)
#pragma unroll
                    for (int n = 0; n < 2; ++n) { const f32x4 v = acc[ai][bj][m][n]; const int col = colbase + bj * 128 + wc * 32 + n * 16 + 4 * fq;
#pragma unroll
                        for (int i = 0; i < 4; ++i) dstT[(size_t)(col + i) * LT + t] = f2bf(act<ACT>(v[i])); } }
    }
    __device__ __forceinline__ void operator()(const f32x4 (&acc)[2][2][4][2], const pg8::Unit& u, int wr, int wc, int fr, int fq) const {
        asm volatile("" : "+v"(fr), "+v"(fq));
        const int pm = u.pm, pn = u.pn;
        const bool isctx = pm >= 64; const int b = isctx ? pm - 64 : (pm >> 5); const int t0 = (isctx ? 0 : (pm & 31) * 256) + wr * 64 + fr;
        const int row0 = pm * 256 + wr * 64 + fr;
        if (isctx && last && pn >= 4) return;
        if (pn < 2 || (pn >= 4 && pn < 6)) {
            const bool isq = pn >= 4; const int hp = isq ? pn - 4 : pn; const int map = wc >> 1, axis = wc & 1;
            bf16* dst = isq ? Q : K; float mx[2] = {0.f, 0.f};
#pragma unroll
            for (int ai = 0; ai < 2; ++ai)
#pragma unroll
                for (int m = 0; m < 4; ++m) { const int t = t0 + ai * 128 + m * 16; const int pos = isctx ? SEQ + t : t;
                    f32x4 cs = (f32x4){1.f, 1.f, 1.f, 1.f}, sn = (f32x4){0.f, 0.f, 0.f, 0.f};
                    if (!isctx) { const int pa = axis ? (t & 63) : (t >> 6); cs = *(const f32x4*)(rope + pa * 16 + 4 * fq); sn = *(const f32x4*)(rope + 2048 + pa * 16 + 4 * fq); }
#pragma unroll
                    for (int bj = 0; bj < 2; ++bj) { const int h = 2 * hp + bj; const f32x4 x1 = acc[ai][bj][m][0], x2 = acc[ai][bj][m][1];
                        f32x4 o1 = x1 * cs - x2 * sn, o2 = x2 * cs + x1 * sn;
                        if (isq) { o1 = o1 * QSCALE; o2 = o2 * QSCALE; }
                        else { float ss = (o1[0] * o1[0] + o1[1] * o1[1]) + (o1[2] * o1[2] + o1[3] * o1[3]) + (o2[0] * o2[0] + o2[1] * o2[1]) + (o2[2] * o2[2] + o2[3] * o2[3]);
                            ss += __shfl_xor(ss, 16); ss += __shfl_xor(ss, 32); mx[bj] = fmaxf(mx[bj], ss); }
                        u32x2 w1, w2; w1.x = pg8::cvt_pk_bf16(o1[0], o1[1]); w1.y = pg8::cvt_pk_bf16(o1[2], o1[3]); w2.x = pg8::cvt_pk_bf16(o2[0], o2[1]); w2.y = pg8::cvt_pk_bf16(o2[2], o2[3]);
                        if (isq) { bf16* rowp = dst + ((size_t)((b * 4 + h) * 2 + map) * KEYS + pos) * 64 + 32 * axis + 4 * fq; *(u32x2*)rowp = w1; *(u32x2*)(rowp + 16) = w2; }
                        else {
                            bf16* rowp = dst + (((((size_t)(b * 4 + h) * 132 + (pos >> 6)) * 2 + map) * 8 + 4 * axis + (fq >> 1)) * 64 + (pos & 63)) * 8 + 4 * (fq & 1);
                            *(u32x2*)rowp = w1; *(u32x2*)(rowp + 2 * 512) = w2; } } }
            if (!isq) {
#pragma unroll
                for (int bj = 0; bj < 2; ++bj) { float mm = mx[bj]; mm = fmaxf(mm, __shfl_xor(mm, 1)); mm = fmaxf(mm, __shfl_xor(mm, 2)); mm = fmaxf(mm, __shfl_xor(mm, 4)); mm = fmaxf(mm, __shfl_xor(mm, 8));
                    if (fr == 0 && fq == 0) atomicMax(kmax + ((b * 4 + 2 * hp + bj) * 2 + map) * 2 + axis, __float_as_uint(mm)); }
            }
        } else if (pn < 4) {
#pragma unroll
            for (int ai = 0; ai < 2; ++ai)
#pragma unroll
                for (int m = 0; m < 4; ++m) { const int t = t0 + ai * 128 + m * 16; const int pos = isctx ? SEQ + t : t;
                    const int pp = (pos & ~12) | ((pos & 4) << 1) | ((pos & 8) >> 1);
#pragma unroll
                    for (int bj = 0; bj < 2; ++bj) { const int h = 2 * (pn - 2) + bj;
#pragma unroll
                        for (int n = 0; n < 2; ++n) { const f32x4 v = acc[ai][bj][m][n]; const int d = wc * 32 + n * 16 + 4 * fq;
#pragma unroll
                            for (int i = 0; i < 4; ++i) Vt[((((size_t)(b * 4 + h) * 132 + (pp >> 6)) * 8 + ((pp & 63) >> 3)) * 128 + d + i) * 8 + (pp & 7)] = f2bf(v[i]); } } }
        } else if (pn < 8) { rowmajor<1>(acc, ga, 512, (pn - 6) * 256, row0, wc, fq);
        } else if (pn < 14) { if (isctx) transposed<0>(acc, zhyTc + (size_t)b * 1536 * CTXL, CTXL, (pn - 8) * 256, t0, wc, fq); else transposed<0>(acc, zhyT + (size_t)b * 1536 * SEQ, SEQ, (pn - 8) * 256, t0, wc, fq);
        } else if (pn < 16) { if (isctx) transposed<1>(acc, gbTc + (size_t)b * 512 * CTXL, CTXL, (pn - 14) * 256, t0, wc, fq); else transposed<1>(acc, gbT + (size_t)b * 512 * SEQ, SEQ, (pn - 14) * 256, t0, wc, fq);
        } else if (pn < 20) { rowmajor<2>(acc, zgm, 1024, (pn - 16) * 256, row0, wc, fq);
        } else if (pn < 22) { rowmajor<1>(acc, gc, 512, (pn - 20) * 256, row0, wc, fq);
        } else { rowmajor<3>(acc, sel, 3072, (pn - 22) * 256, row0, wc, fq); }
    }
};
struct MergeHook {
    static constexpr bool ON = true; const bf16* sel;
    __device__ __forceinline__ void operator()(f32x4 (&acc)[2][2][4][2], const pg8::Unit& u, int wr, int wc, int fr, int fq, int t) const {
        asm volatile("" : "+v"(fr), "+v"(fq));
        const int i = t >> 3;
        const int row0 = u.pm * 256 + wr * 64 + fr, col0 = u.pn * 256 + wc * 32 + 4 * fq;
#pragma unroll
        for (int ai = 0; ai < 2; ++ai)
#pragma unroll
            for (int m = 0; m < 4; ++m) { const bf16* sp = sel + (size_t)(row0 + ai * 128 + m * 16) * 3072 + (i - 1) * 1024 + col0;
#pragma unroll
                for (int bj = 0; bj < 2; ++bj)
#pragma unroll
                    for (int n = 0; n < 2; ++n) { const u32x2 a = *(const u32x2*)(sp + bj * 128 + n * 16), b = *(const u32x2*)(sp + 1024 + bj * 128 + n * 16);
                        f32x4 r; r[0] = bf2f(a.x & 0xffffu) * __builtin_amdgcn_rcpf(fmaxf(bf2f(b.x & 0xffffu), 1e-30f)); r[1] = bf2f(a.x >> 16) * __builtin_amdgcn_rcpf(fmaxf(bf2f(b.x >> 16), 1e-30f));
                        r[2] = bf2f(a.y & 0xffffu) * __builtin_amdgcn_rcpf(fmaxf(bf2f(b.y & 0xffffu), 1e-30f)); r[3] = bf2f(a.y >> 16) * __builtin_amdgcn_rcpf(fmaxf(bf2f(b.y >> 16), 1e-30f));
                        acc[ai][bj][m][n] = acc[ai][bj][m][n] * r; }
                asm volatile("" ::: "memory"); }
    }
};
struct EpiMergeF {
    static constexpr bool PERM = false, AFTER_DRAIN = false;
    const bf16* sel; bf16* outpre;
    __device__ __forceinline__ void operator()(const f32x4 (&acc)[2][2][4][2], const pg8::Unit& u, int wr, int wc, int fr, int fq) const {
        asm volatile("" : "+v"(fr), "+v"(fq));
        const int row0 = u.pm * 256 + wr * 64 + fr, col0 = u.pn * 256 + wc * 32 + 4 * fq;
#pragma unroll
        for (int ai = 0; ai < 2; ++ai)
#pragma unroll
            for (int m = 0; m < 4; ++m) { const size_t row = row0 + ai * 128 + m * 16;
#pragma unroll
                for (int bj = 0; bj < 2; ++bj)
#pragma unroll
                    for (int n = 0; n < 2; ++n) { const int col = col0 + bj * 128 + n * 16;
                        const u32x2 sr = *(const u32x2*)(sel + row * 3072 + 2048 + col);
                        f32x4 v = acc[ai][bj][m][n]; v[0] *= bf2f(sr.x & 0xffffu); v[1] *= bf2f(sr.x >> 16); v[2] *= bf2f(sr.y & 0xffffu); v[3] *= bf2f(sr.y >> 16);
                        u32x2 w; w.x = pg8::cvt_pk_bf16(v[0], v[1]); w.y = pg8::cvt_pk_bf16(v[2], v[3]); *(u32x2*)(outpre + row * 1024 + col) = w; } }
    }
};
struct EpiOut {
    static constexpr bool PERM = false, AFTER_DRAIN = false;
    bf16* out; int last;
    __device__ __forceinline__ void operator()(const f32x4 (&acc)[2][2][4][2], const pg8::Unit& u, int wr, int wc, int fr, int fq) const {
        if (u.pm >= 64 && last) return;
        asm volatile("" : "+v"(fr), "+v"(fq));
        const int row0 = u.pm * 256 + wr * 64 + fr, col0 = u.pn * 256 + wc * 32 + 4 * fq;
#pragma unroll
        for (int ai = 0; ai < 2; ++ai)
#pragma unroll
            for (int m = 0; m < 4; ++m)
#pragma unroll
                for (int bj = 0; bj < 2; ++bj)
#pragma unroll
                    for (int n = 0; n < 2; ++n) { const f32x4 v = acc[ai][bj][m][n]; u32x2 w; w.x = pg8::cvt_pk_bf16(v[0], v[1]); w.y = pg8::cvt_pk_bf16(v[2], v[3]); *(u32x2*)(out + (size_t)(row0 + ai * 128 + m * 16) * 1024 + col0 + bj * 128 + n * 16) = w; }
    }
};
__device__ __forceinline__ void phase0(const Params& p, int wid0) {
    MK_TIDS(wid0)
    unsigned char* ws = p.ws;
    if (blockIdx.x == 0 && tid < 128) ((unsigned*)(ws + WS_CTL))[tid] = 0u;
    { const int gid = blockIdx.x * 512 + tid;
      if (gid < 2048) { const int pa = gid >> 4, f = gid & 15; const float inv = exp2f(-(float)f * (13.287712379549449f / 16.f)); const float ang = (float)pa * inv;
          float* rope = (float*)(ws + WS_ROPE); rope[gid] = cosf(ang); rope[2048 + gid] = sinf(ang); } }
    const int gw = blockIdx.x * 8 + wid, NGW = gridDim.x * 8;
    float* modp = (float*)(ws + WS_MODP);
    for (int it = gw; it < DEPTH * 48 * 8; it += NGW) {
        const int kc = it & 7, cb = (it >> 3) % 48, l = it / (48 * 8); const int col = cb * 64 + lane;
        float sv[3][2];
#pragma unroll
        for (int j = 0; j < 2; ++j) { const int k = kc * 128 + j * 64 + lane;
            sv[0][j] = silu_f(p.in[I_C][k]); sv[1][j] = silu_f(p.in[I_C][1024 + k]); sv[2][j] = silu_f(p.in[I_CCTX][k]); }
        float a0 = 0.f, a1 = 0.f, a2 = 0.f;
        const float* W = p.in[I_ADAW] + ((size_t)l * 1024 + kc * 128) * 3072 + col;
#pragma unroll
        for (int j = 0; j < 2; ++j)
#pragma unroll 16
            for (int kk = 0; kk < 64; ++kk) { const float w = W[(size_t)(j * 64 + kk) * 3072];
                a0 += __shfl(sv[0][j], kk) * w; a1 += __shfl(sv[1][j], kk) * w; a2 += __shfl(sv[2][j], kk) * w; }
        if (kc == 0) { const float bb = p.in[I_ADAB][l * 3072 + col]; a0 += bb; a1 += bb; a2 += bb; }
        float* o = modp + ((size_t)(kc * DEPTH + l) * 3) * 3072 + col;
        o[0] = a0; o[3072] = a1; o[6144] = a2;
    }
}

__device__ __forceinline__ void transpose_item(const float* W, int K, int N, bf16* WT, int ldt, float* scr, int item, int lane) {
    const int nblk = N / 32, kb = item / nblk, nb = item % nblk, k0 = 64 * kb, n0 = 32 * nb;
#pragma unroll 8
    for (int i = 0; i < 32; ++i) { const int kk = 2 * i + (lane >> 5); scr[kk * 33 + (lane & 31)] = W[(size_t)(k0 + kk) * N + n0 + (lane & 31)]; }
    __builtin_amdgcn_s_waitcnt(0); asm volatile("" ::: "memory");
    const int c = lane & 7;
#pragma unroll
    for (int j = 0; j < 4; ++j) { const int n = (lane >> 3) + 8 * j; const float* s = scr + (8 * c) * 33 + n;
        u32x4 o; o.x = pg8::cvt_pk_bf16(s[0 * 33], s[1 * 33]); o.y = pg8::cvt_pk_bf16(s[2 * 33], s[3 * 33]); o.z = pg8::cvt_pk_bf16(s[4 * 33], s[5 * 33]); o.w = pg8::cvt_pk_bf16(s[6 * 33], s[7 * 33]);
        *(u32x4*)(WT + (size_t)(n0 + n) * ldt + k0 + 8 * c) = o; }
    __builtin_amdgcn_s_waitcnt(0); asm volatile("" ::: "memory");
}
__device__ __forceinline__ void filter_item(const Params& p, int l, int Lf, int t0, float* dst, float* hidT  , int wid0) {
    MK_TIDS(wid0)
    const float* w1 = p.in[I_FW1] + l * 33 * 64; const float* b1 = p.in[I_FB1] + l * 64; const float* w2 = p.in[I_FW2] + l * 64 * 64; const float* b2 = p.in[I_FB2] + l * 64;
    const float* w3 = p.in[I_FW3] + (size_t)l * 64 * 1024; const float* fq = p.in[I_FFREQ] + l * 128;
    const float f0 = fq[lane], f1 = fq[64 + lane], bb1 = b1[lane], bb2 = b2[lane];
    float* w1s = hidT + 2048; float* w2s = w1s + 33 * 64;
    { float t1[5], t2[8];
#pragma unroll
      for (int k = 0; k < 5; ++k) { const int idx = tid + 512 * k; t1[k] = idx < 33 * 64 ? w1[idx] : 0.f; }
#pragma unroll
      for (int k = 0; k < 8; ++k) t2[k] = w2[tid + 512 * k];
#pragma unroll
      for (int k = 0; k < 5; ++k) { const int idx = tid + 512 * k; if (idx < 33 * 64) w1s[idx] = t1[k]; }
#pragma unroll
      for (int k = 0; k < 8; ++k) w2s[tid + 512 * k] = t2[k]; }
    __syncthreads();
    { float z[4], a[4], c[4];
#pragma unroll
      for (int pp = 0; pp < 4; ++pp) { const int t = t0 + 4 * wid + pp;
        const float tn = (float)t / (float)(Lf - 1); const float wpos = (6.283185307179586f / (float)Lf) * (float)t;
        float zz = 0.f;
        if (lane == 0) zz = tn;
        else if (lane <= 16) { const float band = 1e-4f + (float)(lane - 1) * ((15.f - 1e-4f) / 15.f); zz = cosf(band * wpos); }
        else if (lane <= 32) { const float band = 1e-4f + (float)(lane - 17) * ((15.f - 1e-4f) / 15.f); zz = -sinf(band * wpos); }
        z[pp] = zz; a[pp] = bb1; c[pp] = bb2; }
#pragma unroll 3
      for (int e = 0; e < 33; ++e) { const float w = w1s[e * 64 + lane];
#pragma unroll
        for (int pp = 0; pp < 4; ++pp) a[pp] += __shfl(z[pp], e) * w; }
#pragma unroll
      for (int pp = 0; pp < 4; ++pp) a[pp] = sinf(f0 * a[pp]);
#pragma unroll 4
      for (int i = 0; i < 64; ++i) { const float w = w2s[i * 64 + lane];
#pragma unroll
        for (int pp = 0; pp < 4; ++pp) c[pp] += __shfl(a[pp], i) * w; }
#pragma unroll
      for (int pp = 0; pp < 4; ++pp) hidT[lane * 32 + 4 * wid + pp] = sinf(f1 * c[pp]); }
    __syncthreads();
    float acc0[32], acc1[32];
#pragma unroll
    for (int i = 0; i < 32; ++i) { acc0[i] = 0.f; acc1[i] = 0.f; }
#pragma unroll 16
    for (int j = 0; j < 64; ++j) {
        const float wa = w3[j * 1024 + tid], wb = w3[j * 1024 + 512 + tid];
#pragma unroll
        for (int g = 0; g < 8; ++g) { const f32x4 hv = *(const f32x4*)(hidT + j * 32 + 4 * g);
#pragma unroll
            for (int i = 0; i < 4; ++i) { acc0[4 * g + i] += hv[i] * wa; acc1[4 * g + i] += hv[i] * wb; } }
    }
    const float dmin = -3.0701134573253945f, dmax = -15.350567286626973f;
    const float delta = fabsf(dmin + (float)tid * ((dmax - dmin) / 511.f));
#pragma unroll
    for (int g = 0; g < 8; ++g) { f32x4 o0, o1;
#pragma unroll
        for (int i = 0; i < 4; ++i) { const float tn = (float)(t0 + 4 * g + i) / (float)(Lf - 1); const float wdw = __expf(-tn * delta); o0[i] = acc0[4 * g + i] * wdw; o1[i] = acc1[4 * g + i] * wdw; }
        *(f32x4*)(dst + (size_t)tid * Lf + t0 + 4 * g) = o0; *(f32x4*)(dst + (size_t)(512 + tid) * Lf + t0 + 4 * g) = o1; }
    __syncthreads();
}
__device__ __forceinline__ void phaseA(const Params& p, int l, unsigned char* lds, int wid0) {
    MK_TIDS(wid0)
    unsigned char* ws = p.ws;
    float* vA = (float*)lds; float* vSH = vA + 3072; float* vGTP = vSH + 3072;
    const float* modp = (const float*)(ws + WS_MODP);
    for (int idx = tid; idx < 3072; idx += 512) { const int cond = idx >> 10, col = idx & 1023;
        if (l < DEPTH) { float sh = 0.f, sc = 0.f;
#pragma unroll
            for (int kc = 0; kc < 8; ++kc) { const float* o = modp + ((size_t)(kc * DEPTH + l) * 3 + cond) * 3072; sh += o[col]; sc += o[1024 + col]; }
            vA[idx] = p.in[I_NPRE][l * 1024 + col] * (1.f + sc); vSH[idx] = sh; }
        if (l > 0) { float gt = 0.f;
#pragma unroll
            for (int kc = 0; kc < 8; ++kc) gt += modp[((size_t)(kc * DEPTH + (l - 1)) * 3 + cond) * 3072 + 2048 + col];
            vGTP[idx] = gt * p.in[I_NPOST][(l - 1) * 1024 + col]; } }
    __syncthreads();
    const int gw = blockIdx.x * 8 + wid, NGW = gridDim.x * 8;
    const bf16* outb = (const bf16*)(ws + WS_OUT); bf16* hb = (bf16*)(ws + WS_H); float* xc = (float*)(ws + WS_XC);
    const int nrows = (l < DEPTH) ? MROWS : MLAT;
    for (int r0 = gw; r0 < nrows; r0 += 2 * NGW) {
        const int r1 = r0 + NGW; const bool two = r1 < nrows;
        f32x4 v[2][4], o[2][4]; const float* xs[2]; float* xd[2]; int cond[2]; int rr[2] = {r0, two ? r1 : r0};
#pragma unroll
        for (int k = 0; k < 2; ++k) { const int r = rr[k]; const bool isctx = r >= MLAT; cond[k] = isctx ? 2 : (r >> 13);
            if (!isctx) { xs[k] = (l <= 1 ? p.in[I_X] : p.out) + (size_t)r * 1024; xd[k] = p.out + (size_t)r * 1024; }
            else { xs[k] = (l <= 1 ? p.in[I_CTX] : xc) + (size_t)(r - MLAT) * 1024; xd[k] = xc + (size_t)(r - MLAT) * 1024; }
#pragma unroll
            for (int j = 0; j < 4; ++j) v[k][j] = *(const f32x4*)(xs[k] + 4 * lane + 256 * j);
            if (l > 0) {
#pragma unroll
                for (int j = 0; j < 4; ++j) { const u32x2 w = *(const u32x2*)(outb + (size_t)r * 1024 + 4 * lane + 256 * j); o[k][j] = (f32x4){bf2f(w.x & 0xffffu), bf2f(w.x >> 16), bf2f(w.y & 0xffffu), bf2f(w.y >> 16)}; } } }
        if (l > 0) { float ss[2];
#pragma unroll
            for (int k = 0; k < 2; ++k) { ss[k] = 0.f;
#pragma unroll
                for (int j = 0; j < 4; ++j) ss[k] += (o[k][j][0] * o[k][j][0] + o[k][j][1] * o[k][j][1]) + (o[k][j][2] * o[k][j][2] + o[k][j][3] * o[k][j][3]); }
            ss[0] = wave_sum(ss[0]); ss[1] = wave_sum(ss[1]);
#pragma unroll
            for (int k = 0; k < 2; ++k) { const float rinv = rsqrtf(ss[k] * (1.f / 1024.f) + EPSN);
                if (k == 0 || two) {
#pragma unroll
                    for (int j = 0; j < 4; ++j) { const f32x4 g = *(const f32x4*)(vGTP + cond[k] * 1024 + 4 * lane + 256 * j); v[k][j] = v[k][j] + g * o[k][j] * rinv; *(f32x4*)(xd[k] + 4 * lane + 256 * j) = v[k][j]; } } } }
        if (l < DEPTH) { float ss[2];
#pragma unroll
            for (int k = 0; k < 2; ++k) { ss[k] = 0.f;
#pragma unroll
                for (int j = 0; j < 4; ++j) ss[k] += (v[k][j][0] * v[k][j][0] + v[k][j][1] * v[k][j][1]) + (v[k][j][2] * v[k][j][2] + v[k][j][3] * v[k][j][3]); }
            ss[0] = wave_sum(ss[0]); ss[1] = wave_sum(ss[1]);
#pragma unroll
            for (int k = 0; k < 2; ++k) { const float rinv = rsqrtf(ss[k] * (1.f / 1024.f) + EPSN);
                if (k == 0 || two) {
#pragma unroll
                    for (int j = 0; j < 4; ++j) { const f32x4 a = *(const f32x4*)(vA + cond[k] * 1024 + 4 * lane + 256 * j), sh = *(const f32x4*)(vSH + cond[k] * 1024 + 4 * lane + 256 * j);
                        const f32x4 h = v[k][j] * rinv * a + sh; u32x2 w; w.x = pg8::cvt_pk_bf16(h[0], h[1]); w.y = pg8::cvt_pk_bf16(h[2], h[3]); *(u32x2*)(hb + (size_t)rr[k] * 1024 + 4 * lane + 256 * j) = w; } } } }
    }
    if (l >= DEPTH) return;
    for (int rep = 0; rep < REP_A2; ++rep) {
    { float* scr = (float*)(lds + 36864 + wid * 8448);
      constexpr int I_IN = 16 * 272, I_BR = 8 * 32, I_O = 16 * 32;
      for (int it = gw; it < I_IN + 3 * I_BR + I_O; it += NGW) { int r = it;
          if (r < I_IN) { transpose_item(p.in[I_WIN] + (size_t)l * 1024 * NCOL, 1024, NCOL, (bf16*)(ws + WS_WIN), 1024, scr, r, lane); continue; } r -= I_IN;
          if (r < 3 * I_BR) { const int i = r / I_BR; transpose_item(p.in[I_WBR] + ((size_t)l * 3 + i) * 512 * 1024, 512, 1024, (bf16*)(ws + WS_WBR) + (size_t)i * 512, 1536, scr, r % I_BR, lane); continue; } r -= 3 * I_BR;
          transpose_item(p.in[I_WOUT] + (size_t)l * 1024 * 1024, 1024, 1024, (bf16*)(ws + WS_WOUT), 1024, scr, r, lane); } }
    { float* hidT = (float*)(lds + 104448);
      for (int it = blockIdx.x; it < 256; it += gridDim.x) filter_item(p, l, SEQ, 32 * it, (float*)(ws + WS_FILT), hidT, wid0);
      }
    __syncthreads();
    }
}
__device__ __forceinline__ float sumsq8(bf16x8 v) { float s = 0.f;
#pragma unroll
    for (int j = 0; j < 8; ++j) { const float f = bf2f((unsigned)(unsigned short)v[j]); s += f * f; } return s; }
__device__ __forceinline__ bf16x8 pack8(const f32x16& S, int o) { u32x4 w; w.x = pg8::cvt_pk_bf16(S[o + 0], S[o + 1]); w.y = pg8::cvt_pk_bf16(S[o + 2], S[o + 3]); w.z = pg8::cvt_pk_bf16(S[o + 4], S[o + 5]); w.w = pg8::cvt_pk_bf16(S[o + 6], S[o + 7]); return __builtin_bit_cast(bf16x8, w); }
__device__ __forceinline__ void attn_unit(const Params& p, int l, int b, int h, int qpos0, int kbeg, int nkt, int grow0, float lam, float lam_init, unsigned char* lds, int wid0) {
    MK_TIDS(wid0)
    unsigned char* ws = p.ws;
    const bf16* Q = (const bf16*)(ws + WS_Q); const bf16* K = (const bf16*)(ws + WS_K); const bf16* Vt = (const bf16*)(ws + WS_VT);
    const bf16* ga = (const bf16*)(ws + WS_GA); bf16* gated = (bf16*)(ws + WS_GATED);
    const unsigned* kmax = (const unsigned*)(ws + WS_CTL) + l * 32;
    const int r32 = lane & 31, hi = lane >> 5, bh = b * 4 + h, qg = wid >> 1, map = wid & 1;
    bf16x8 qf[4]; float Msh;
    f32x16 o[4];
#pragma unroll
    for (int db = 0; db < 4; ++db)
#pragma unroll
        for (int r = 0; r < 16; ++r) o[db][r] = 0.f;
    float lsum = 0.f;
    LAS unsigned char* ldsl = (LAS unsigned char*)lds;
    const bf16* kt_g = K + (size_t)bh * 132 * 8192 + (size_t)(2 * wid) * 512 + lane * 8; const bf16* vt_g = Vt + (size_t)bh * 132 * 8192 + (size_t)(2 * wid) * 512 + lane * 8;
#define AT_DMA(tile, buf) do { const bf16* kp_ = kt_g + (size_t)(tile) * 8192; const bf16* vp_ = vt_g + (size_t)(tile) * 8192; LAS unsigned char* lb_ = ldsl + (buf) * 32768 + (2 * wid) * 1024; \
        __builtin_amdgcn_global_load_lds((const unsigned*)kp_, (LAS unsigned*)lb_, 16, 0, 0); __builtin_amdgcn_global_load_lds((const unsigned*)(kp_ + 512), (LAS unsigned*)(lb_ + 1024), 16, 0, 0); \
        __builtin_amdgcn_global_load_lds((const unsigned*)vp_, (LAS unsigned*)(lb_ + 16384), 16, 0, 0); __builtin_amdgcn_global_load_lds((const unsigned*)(vp_ + 512), (LAS unsigned*)(lb_ + 16384 + 1024), 16, 0, 0); } while (0)
    const int kt0 = kbeg >> 6;
#define AT_LDK(bufoff, kbi) do { _Pragma("unroll") for (int s_ = 0; s_ < 4; ++s_) kf[s_] = *(const LAS bf16x8*)(kl_ + (bufoff) + ((2 * s_) * 64 + 32 * (kbi)) * 16); } while (0)
#define AT_LDV(bufoff, kbi) do { _Pragma("unroll") for (int db_ = 0; db_ < 4; ++db_) { vf[2 * db_] = *(const LAS bf16x8*)(vl_ + (bufoff) + ((4 * (kbi)) * 128 + 32 * db_) * 16); vf[2 * db_ + 1] = *(const LAS bf16x8*)(vl_ + (bufoff) + ((4 * (kbi) + 2) * 128 + 32 * db_) * 16); } } while (0)
#define AT_MQK(dst) do { dst = __builtin_amdgcn_mfma_f32_32x32x16_bf16(kf[0], qf[0], negm, 0, 0, 0); _Pragma("unroll") for (int s_ = 1; s_ < 4; ++s_) dst = __builtin_amdgcn_mfma_f32_32x32x16_bf16(kf[s_], qf[s_], dst, 0, 0, 0); } while (0)
#define AT_MPV(pk0_, pk1_) do { _Pragma("unroll") for (int db_ = 0; db_ < 4; ++db_) { o[db_] = __builtin_amdgcn_mfma_f32_32x32x16_bf16(pk0_, vf[2 * db_], o[db_], 0, 0, 0); o[db_] = __builtin_amdgcn_mfma_f32_32x32x16_bf16(pk1_, vf[2 * db_ + 1], o[db_], 0, 0, 0); } } while (0)
#define AT_SM(src, pk0_, pk1_) do { float ls_ = 0.f; _Pragma("unroll") for (int r_ = 0; r_ < 16; ++r_) { src[r_] = __builtin_amdgcn_exp2f(src[r_]); ls_ += src[r_]; } lsum += ls_; pk0_ = pack8(src, 0); pk1_ = pack8(src, 8); } while (0)
#define AT_SB() __builtin_amdgcn_sched_barrier(0)
    const LAS unsigned char* kl_ = ldsl + ((map * 8 + hi) * 64 + r32) * 16; const LAS unsigned char* vl_ = ldsl + 16384 + (hi * 128 + r32) * 16;
    AT_DMA(kt0, 0); if (nkt > 1) AT_DMA(kt0 + 1, 1); if (nkt > 2) AT_DMA(kt0 + 2, 2);
    { const bf16* qp = Q + ((size_t)(bh * 2 + map) * KEYS + qpos0 + qg * 32 + r32) * 64 + hi * 8;
#pragma unroll
        for (int s = 0; s < 4; ++s) qf[s] = *(const bf16x8*)(qp + 16 * s);
        float nA = sumsq8(qf[0]) + sumsq8(qf[1]), nB = sumsq8(qf[2]) + sumsq8(qf[3]);
        nA += __shfl_xor(nA, 32); nB += __shfl_xor(nB, 32);
        const float kA = __uint_as_float(kmax[(bh * 2 + map) * 2 + 0]), kB = __uint_as_float(kmax[(bh * 2 + map) * 2 + 1]);
        Msh = sqrtf(nA * kA) + sqrtf(nB * kB); }
    asm volatile("s_waitcnt vmcnt(0)" ::: "memory"); __syncthreads();
    f32x16 Sc, Sn, negm; bf16x8 kf[4], vf[8];
#pragma unroll
    for (int r = 0; r < 16; ++r) negm[r] = -Msh;
    asm volatile("" : "+v"(negm));
    AT_LDK(0, 0); AT_MQK(Sc);
    bf16x8 pA0, pA1, pB0, pB1;
#pragma unroll
    for (int j = 0; j < 8; ++j) { pA0[j] = 0; pA1[j] = 0; }
    int bop = 98304, bo = 0, bo1 = 32768, bo2 = 65536;
    for (int it = 0; it < nkt; ++it) {
        AT_LDK(bo, 1); AT_LDV((it ? bop : bo), 1); AT_SB();
        AT_SM(Sc, pB0, pB1); AT_SB();
        __builtin_amdgcn_s_setprio(1); AT_MQK(Sn); AT_MPV(pA0, pA1); __builtin_amdgcn_s_setprio(0); AT_SB();
        if (it + 2 < nkt) asm volatile("s_waitcnt vmcnt(4)" ::: "memory"); else asm volatile("s_waitcnt vmcnt(0)" ::: "memory");
        __syncthreads();
        if (it + 3 < nkt) AT_DMA(kt0 + it + 3, (bop >> 15));
        if (it + 1 < nkt) AT_LDK(bo1, 0);
        AT_LDV(bo, 0); AT_SB();
        AT_SM(Sn, pA0, pA1); AT_SB();
        __builtin_amdgcn_s_setprio(1); if (it + 1 < nkt) AT_MQK(Sc);
        AT_MPV(pB0, pB1); __builtin_amdgcn_s_setprio(0); AT_SB();
        const int tb = bop; bop = bo; bo = bo1; bo1 = bo2; bo2 = tb;
    }
    AT_LDV(bop, 1); AT_MPV(pA0, pA1);
    __syncthreads();
#undef AT_LDK
#undef AT_LDV
#undef AT_MQK
#undef AT_MPV
#undef AT_SM
#undef AT_SB
#undef AT_DMA
    lsum += __shfl_xor(lsum, 32);
    float* wsf = (float*)(lds + 131072) + wid * 32;
    if (hi == 0) wsf[r32] = (map == 0 ? 1.f : lam) / lsum;
    __builtin_amdgcn_s_waitcnt(0); asm volatile("" ::: "memory");
    float* xch = (float*)lds + qg * (32 * 132);
    if (map == 1) {
#pragma unroll
        for (int r = 0; r < 16; ++r) { const int q = crow(r, hi); const float c = wsf[q];
#pragma unroll
            for (int db = 0; db < 4; ++db) xch[q * 132 + 32 * db + r32] = o[db][r] * c; }
    }
    __syncthreads();
    if (map == 0) {
        const float* sg = p.in[I_SUBLN] + l * 128; float g4[4];
#pragma unroll
        for (int db = 0; db < 4; ++db) g4[db] = sg[32 * db + r32] * (1.f - lam_init);
        bf16 gv[16][4];
#pragma unroll
        for (int r = 0; r < 16; ++r) { const size_t grow = (size_t)grow0 + qg * 32 + crow(r, hi);
#pragma unroll
            for (int db = 0; db < 4; ++db) gv[r][db] = ga[grow * 512 + h * 128 + 32 * db + r32]; }
#pragma unroll
        for (int r = 0; r < 16; ++r) { const int q = crow(r, hi); const float a = wsf[q]; float v[4]; float ss = 0.f;
#pragma unroll
            for (int db = 0; db < 4; ++db) { v[db] = o[db][r] * a - xch[q * 132 + 32 * db + r32]; ss += v[db] * v[db]; }
            ss += __shfl_xor(ss, 1); ss += __shfl_xor(ss, 2); ss += __shfl_xor(ss, 4); ss += __shfl_xor(ss, 8); ss += __shfl_xor(ss, 16);
            const float rinv = rsqrtf(ss * (1.f / 128.f) + EPSN); const size_t grow = (size_t)grow0 + qg * 32 + q;
#pragma unroll
            for (int db = 0; db < 4; ++db) { const int col = h * 128 + 32 * db + r32; gated[grow * 1536 + col] = f2bf(v[db] * rinv * g4[db] * bf2f(gv[r][db])); } }
    }
    __syncthreads();
}

struct cf { float x, y; };
__device__ __forceinline__ cf cadd(cf a, cf b) { return {a.x + b.x, a.y + b.y}; }
__device__ __forceinline__ cf csub(cf a, cf b) { return {a.x - b.x, a.y - b.y}; }
__device__ __forceinline__ cf cmul(cf a, cf b) { return {a.x * b.x - a.y * b.y, a.x * b.y + a.y * b.x}; }
__device__ __forceinline__ cf cmulc(cf a, cf b) { return {a.x * b.x + a.y * b.y, a.y * b.x - a.x * b.y}; }
template <bool INV> __device__ __forceinline__ void dft4(cf& a0, cf& a1, cf& a2, cf& a3) {
    const cf t0 = cadd(a0, a2), t1 = csub(a0, a2), t2 = cadd(a1, a3), t3 = csub(a1, a3);
    a0 = cadd(t0, t2); a2 = csub(t0, t2);
    if (!INV) { a1 = {t1.x + t3.y, t1.y - t3.x}; a3 = {t1.x - t3.y, t1.y + t3.x}; }
    else      { a1 = {t1.x - t3.y, t1.y + t3.x}; a3 = {t1.x + t3.y, t1.y - t3.x}; }
}
#define W16C(m) ((m) == 0 ? 1.f : (m) == 1 ? 0.9238795325112867f : (m) == 2 ? 0.7071067811865476f : (m) == 3 ? 0.3826834323650898f : (m) == 4 ? 0.f : (m) == 6 ? -0.7071067811865476f : (m) == 9 ? -0.9238795325112867f : 0.f)
#define W16S(m) ((m) == 0 ? 0.f : (m) == 1 ? 0.3826834323650898f : (m) == 2 ? 0.7071067811865476f : (m) == 3 ? 0.9238795325112867f : (m) == 4 ? 1.f : (m) == 6 ? 0.7071067811865476f : (m) == 9 ? -0.3826834323650898f : 0.f)
template <bool INV> __device__ __forceinline__ void dft16(cf (&a)[16]) {
#pragma unroll
    for (int n2 = 0; n2 < 4; ++n2) dft4<INV>(a[n2], a[4 + n2], a[8 + n2], a[12 + n2]);
#pragma unroll
    for (int k1 = 1; k1 < 4; ++k1)
#pragma unroll
        for (int n2 = 1; n2 < 4; ++n2) { const cf w = {W16C(n2 * k1), W16S(n2 * k1)};
            a[4 * k1 + n2] = INV ? cmul(a[4 * k1 + n2], w) : cmulc(a[4 * k1 + n2], w); }
#pragma unroll
    for (int k1 = 0; k1 < 4; ++k1) dft4<INV>(a[4 * k1 + 0], a[4 * k1 + 1], a[4 * k1 + 2], a[4 * k1 + 3]);
}
__device__ __forceinline__ int fidx(int e) { return e + ((e >> 6) << 2); }
template <bool INV, int LQ> __device__ __forceinline__ void fft_pass16(f32x2* X, int tid) {
    constexpr int q = 1 << LQ, STR = q + 4 * (q >> 6);
#pragma unroll 1
    for (int gg = 0; gg < 2; ++gg) {
        const int g = tid + 512 * gg, blk = g >> LQ, i = g & (q - 1), base = (blk << (LQ + 4)) + i;
        f32x2* xb = X + fidx(base);
        cf a[16];
#pragma unroll
        for (int j = 0; j < 16; ++j) { const f32x2 v = xb[j * STR]; a[j] = {v.x, v.y}; }
        const float rev = (float)i * (1.f / (float)(16 << LQ));
        const cf w1 = {__builtin_amdgcn_cosf(rev), __builtin_amdgcn_sinf(rev)};
        if (!INV) {
            dft16<false>(a);
            cf w = w1;
#pragma unroll
            for (int k = 1; k < 16; ++k) { const int src = 4 * (k & 3) + (k >> 2);
                const cf y = cmulc(a[src], w); xb[k * STR] = (f32x2){y.x, y.y}; w = cmul(w, w1); }
            xb[0] = (f32x2){a[0].x, a[0].y};
        } else {
            cf w = w1;
#pragma unroll
            for (int k = 1; k < 16; ++k) { a[k] = cmul(a[k], w); w = cmul(w, w1); }
            dft16<true>(a);
#pragma unroll
            for (int k = 0; k < 16; ++k) { const int src = 4 * (k & 3) + (k >> 2); xb[k * STR] = (f32x2){a[src].x, a[src].y}; }
        }
    }
}
template <bool INV> __device__ __forceinline__ void fft_pass4(f32x2* X, int tid) {
#pragma unroll 4
    for (int gg = 0; gg < 8; ++gg) { const int g = tid + 512 * gg; f32x2* xp = X + fidx(4 * g);
        const f32x4 v01 = *(const f32x4*)xp, v23 = *(const f32x4*)(xp + 2);
        cf a0 = {v01[0], v01[1]}, a1 = {v01[2], v01[3]}, a2 = {v23[0], v23[1]}, a3 = {v23[2], v23[3]};
        dft4<INV>(a0, a1, a2, a3);
        *(f32x4*)xp = (f32x4){a0.x, a0.y, a1.x, a1.y}; *(f32x4*)(xp + 2) = (f32x4){a2.x, a2.y, a3.x, a3.y}; }
}
__device__ __forceinline__ float block_sum(float v, float* red, int lane, int wid) {
    v = wave_sum(v); __syncthreads(); if (lane == 0) red[wid] = v; __syncthreads();
    float s = 0.f;
#pragma unroll
    for (int i = 0; i < 8; ++i) s += red[i];
    return s;
}
__device__ __forceinline__ float zat(const bf16* z, int t, int L) { return (t >= 0 && t < L) ? bf2f(z[t]) : 0.f; }
__device__ __forceinline__ float sconv(const bf16* z, int t, int L, float w0, float w1, float w2, float bb) { return w0 * zat(z, t - 1, L) + w1 * zat(z, t, L) + w2 * zat(z, t + 1, L) + bb; }
__device__ __forceinline__ void ld10(const bf16* row, int t0, float (&o)[10]) {
    const u32x4 raw = *(const u32x4*)(row + t0);
    o[0] = t0 > 0 ? bf2f(row[t0 - 1]) : 0.f; o[9] = t0 + 8 < SEQ ? bf2f(row[t0 + 8]) : 0.f;
    o[1] = bf2f(raw.x & 0xffffu); o[2] = bf2f(raw.x >> 16); o[3] = bf2f(raw.y & 0xffffu); o[4] = bf2f(raw.y >> 16); o[5] = bf2f(raw.z & 0xffffu); o[6] = bf2f(raw.z >> 16); o[7] = bf2f(raw.w & 0xffffu); o[8] = bf2f(raw.w >> 16);
}
__device__ __forceinline__ void hyena_channel(const Params& p, int l, int c, unsigned char* lds, int wid0) {
    MK_TIDS(wid0)
    unsigned char* ws = p.ws;
    f32x2* X = (f32x2*)lds; float* red = (float*)(lds + 139264);
    const float* filt = (const float*)(ws + WS_FILT);
    const float* sw = p.in[I_SW] + l * 3 * 1536; const float* sb = p.in[I_SB] + l * 1536;
    const float w00 = sw[c], w01 = sw[1536 + c], w02 = sw[3072 + c], b0 = sb[c];
    const float w10 = sw[512 + c], w11 = sw[1536 + 512 + c], w12 = sw[3072 + 512 + c], b1 = sb[512 + c];
    const float w20 = sw[1024 + c], w21 = sw[1536 + 1024 + c], w22 = sw[3072 + 1024 + c], b2 = sb[1024 + c];
    const float hbias = p.in[I_HBIAS][l * 512 + c];
    const bf16* zT = (const bf16*)(ws + WS_ZHYT);
    f32x2* Kfg = (f32x2*)(ws + WS_H) + (size_t)blockIdx.x * 16384;
    float ssq = 0.f;
#pragma unroll 1
    for (int it = 0; it < 2; ++it) {
        if (it == 0) {
            const float* ff = filt + (size_t)c * SEQ; const float* fb = filt + (size_t)(512 + c) * SEQ;
#pragma unroll 4
            for (int j = 0; j < 8; ++j) { const int e0 = 4 * tid + 2048 * j; f32x4 v;
                if (e0 < SEQ) v = *(const f32x4*)(ff + e0);
                else { const int d0 = 16384 - e0; const f32x4 a = *(const f32x4*)(fb + d0 - 4); const float bq = d0 < SEQ ? fb[d0] : 0.f; v = (f32x4){bq, a[3], a[2], a[1]}; }
                ssq += (v[0] * v[0] + v[1] * v[1]) + (v[2] * v[2] + v[3] * v[3]);
                f32x2* xp = X + fidx(e0); *(f32x4*)xp = (f32x4){v[0], 0.f, v[1], 0.f}; *(f32x4*)(xp + 2) = (f32x4){v[2], 0.f, v[3], 0.f}; }
        } else {
#pragma unroll 1
            for (int j = 0; j < 2; ++j) { const int t0 = 8 * tid + 4096 * j; float u[2][8];
#pragma unroll
                for (int b = 0; b < 2; ++b) { const bf16* zb = zT + (size_t)(b * 1536 + c) * SEQ; float r1[10], r2[10]; ld10(zb + (size_t)512 * SEQ, t0, r1); ld10(zb + (size_t)1024 * SEQ, t0, r2);
#pragma unroll
                    for (int i = 0; i < 8; ++i) u[b][i] = (w10 * r1[i] + w11 * r1[i + 1] + w12 * r1[i + 2] + b1) * (w20 * r2[i] + w21 * r2[i + 1] + w22 * r2[i + 2] + b2); }
                f32x2* xp = X + fidx(t0); f32x2* xz = X + fidx(t0 + SEQ);
#pragma unroll
                for (int i = 0; i < 4; ++i) { *(f32x4*)(xp + 2 * i) = (f32x4){u[0][2 * i], u[1][2 * i], u[0][2 * i + 1], u[1][2 * i + 1]}; *(f32x4*)(xz + 2 * i) = (f32x4){0.f, 0.f, 0.f, 0.f}; } }
        }
        __syncthreads();
        fft_pass16<false, 10>(X, tid); __syncthreads();
        fft_pass16<false, 6>(X, tid); __syncthreads();
        fft_pass16<false, 2>(X, tid); __syncthreads();
        if (it == 0) {
#pragma unroll 4
            for (int j = 0; j < 8; ++j) { const int e0 = 4 * tid + 2048 * j; const f32x2* xp = X + fidx(e0);
                const f32x4 v01 = *(const f32x4*)xp, v23 = *(const f32x4*)(xp + 2);
                cf a0 = {v01[0], v01[1]}, a1 = {v01[2], v01[3]}, a2 = {v23[0], v23[1]}, a3 = {v23[2], v23[3]};
                dft4<false>(a0, a1, a2, a3);
                *(f32x4*)(Kfg + e0) = (f32x4){a0.x, a0.y, a1.x, a1.y}; *(f32x4*)(Kfg + e0 + 2) = (f32x4){a2.x, a2.y, a3.x, a3.y}; }
        } else {
#pragma unroll 4
            for (int j = 0; j < 8; ++j) { const int e0 = 4 * tid + 2048 * j; f32x2* xp = X + fidx(e0);
                const f32x4 k01 = *(const f32x4*)(Kfg + e0), k23 = *(const f32x4*)(Kfg + e0 + 2); const f32x4 v01 = *(const f32x4*)xp, v23 = *(const f32x4*)(xp + 2);
                cf a0 = {v01[0], v01[1]}, a1 = {v01[2], v01[3]}, a2 = {v23[0], v23[1]}, a3 = {v23[2], v23[3]};
                dft4<false>(a0, a1, a2, a3);
                a0 = cmul(a0, {k01[0], k01[1]}); a1 = cmul(a1, {k01[2], k01[3]}); a2 = cmul(a2, {k23[0], k23[1]}); a3 = cmul(a3, {k23[2], k23[3]});
                dft4<true>(a0, a1, a2, a3);
                *(f32x4*)xp = (f32x4){a0.x, a0.y, a1.x, a1.y}; *(f32x4*)(xp + 2) = (f32x4){a2.x, a2.y, a3.x, a3.y}; }
        }
        __syncthreads();
    }
    fft_pass16<true, 2>(X, tid); __syncthreads();
    fft_pass16<true, 6>(X, tid); __syncthreads();
    fft_pass16<true, 10>(X, tid); __syncthreads();
    const float tot = block_sum(ssq, red, lane, wid);
    const float scale = rsqrtf(tot) * (1.f / 16384.f);
    const bf16* gbT = (const bf16*)(ws + WS_GBT); bf16* gated = (bf16*)(ws + WS_GATED) + 512;
#pragma unroll 1
    for (int j = 0; j < 2; ++j) { const int t0 = 8 * tid + 4096 * j; const f32x2* xp = X + fidx(t0);
        float y[2][8];
#pragma unroll
        for (int i = 0; i < 4; ++i) { const f32x4 v = *(const f32x4*)(xp + 2 * i); y[0][2 * i] = v[0]; y[1][2 * i] = v[1]; y[0][2 * i + 1] = v[2]; y[1][2 * i + 1] = v[3]; }
#pragma unroll
        for (int b = 0; b < 2; ++b) { const bf16* zb = zT + (size_t)(b * 1536 + c) * SEQ; float r0[10], r1[10], r2[10]; ld10(zb, t0, r0); ld10(zb + (size_t)512 * SEQ, t0, r1); ld10(zb + (size_t)1024 * SEQ, t0, r2);
            const u32x4 graw = *(const u32x4*)(gbT + (size_t)(b * 512 + c) * SEQ + t0);
            float g[8]; g[0] = bf2f(graw.x & 0xffffu); g[1] = bf2f(graw.x >> 16); g[2] = bf2f(graw.y & 0xffffu); g[3] = bf2f(graw.y >> 16); g[4] = bf2f(graw.z & 0xffffu); g[5] = bf2f(graw.z >> 16); g[6] = bf2f(graw.w & 0xffffu); g[7] = bf2f(graw.w >> 16);
            bf16* gp = gated + ((size_t)b * SEQ + t0) * 1536 + c;
#pragma unroll
            for (int i = 0; i < 8; ++i) { const float x0 = w00 * r0[i] + w01 * r0[i + 1] + w02 * r0[i + 2] + b0; const float uu = (w10 * r1[i] + w11 * r1[i + 1] + w12 * r1[i + 2] + b1) * (w20 * r2[i] + w21 * r2[i + 1] + w22 * r2[i + 2] + b2);
                gp[(size_t)i * 1536] = f2bf(x0 * (y[b][i] * scale + hbias * uu) * g[i]); } } }
    __syncthreads();
}
__device__ __forceinline__ void hyena_ctx_pair(const Params& p, int l, int item0, unsigned char* lds, int wid0) {
    MK_TIDS(wid0)
    unsigned char* ws = p.ws;
    const int hsel = tid >> 8, t = tid & 255, item = item0 + hsel, b = item >> 9, c = item & 511;
    float* us = (float*)lds + hsel * 1024; float* kf = us + 256; float* kb = kf + 256; float* red = (float*)lds + 2048;
    const float* filt = (const float*)(ws + WS_FILTC) + (size_t)l * 262144;
    const float* sw = p.in[I_SW] + l * 3 * 1536; const float* sb = p.in[I_SB] + l * 1536;
    const bf16* z0 = (const bf16*)(ws + WS_ZHYTC) + (size_t)(b * 1536 + c) * CTXL;
    const float x0 = sconv(z0, t, CTXL, sw[c], sw[1536 + c], sw[3072 + c], sb[c]);
    const float x1 = sconv(z0 + 512 * CTXL, t, CTXL, sw[512 + c], sw[1536 + 512 + c], sw[3072 + 512 + c], sb[512 + c]);
    const float vv = sconv(z0 + 1024 * CTXL, t, CTXL, sw[1024 + c], sw[1536 + 1024 + c], sw[3072 + 1024 + c], sb[1024 + c]);
    const float uu = x1 * vv; const float fa = filt[(size_t)c * CTXL + t], fb = filt[(size_t)(512 + c) * CTXL + t];
    const float g = bf2f(((const bf16*)(ws + WS_GBTC))[(size_t)(b * 512 + c) * CTXL + t]); const float hb = p.in[I_HBIAS][l * 512 + c];
    us[t] = uu; kf[t] = fa; kb[t] = fb;
    const float ssq = wave_sum(fa * fa + (t >= 1 ? fb * fb : 0.f));
    if (lane == 0) red[wid] = ssq;
    __syncthreads();
    const float tot = (red[4 * hsel] + red[4 * hsel + 1]) + (red[4 * hsel + 2] + red[4 * hsel + 3]);
    float acc0 = 0.f, acc1 = 0.f;
#pragma unroll 8
    for (int s = 0; s < 256; s += 2) { acc0 += (s <= t ? kf[t - s] : kb[s - t]) * us[s]; acc1 += (s + 1 <= t ? kf[t - s - 1] : kb[s + 1 - t]) * us[s + 1]; }
    const float y = (acc0 + acc1) * rsqrtf(tot);
    bf16* gated = (bf16*)(ws + WS_GATED) + 512;
    gated[((size_t)MLAT + b * CTXL + t) * 1536 + c] = f2bf(x0 * (y + hb * uu) * g);
    __syncthreads();
}
__device__ __forceinline__ void gmlp_item(const Params& p, int l, int row0, int hf, unsigned char* lds, int wid0) {
    MK_TIDS(wid0)
    unsigned char* ws = p.ws;
    bf16* vT = (bf16*)lds;
    const bf16* zgm = (const bf16*)(ws + WS_ZGM); const bf16* gc = (const bf16*)(ws + WS_GC); bf16* gated = (bf16*)(ws + WS_GATED) + 1024;
    const float* lg = p.in[I_LNG] + l * 512 + 8 * lane; const float* lb = p.in[I_LNB] + l * 512 + 8 * lane;
    float g8[8], b8[8];
#pragma unroll
    for (int i = 0; i < 8; ++i) { g8[i] = lg[i]; b8[i] = lb[i]; }
#pragma unroll 1
    for (int hb = 0; hb < 2; ++hb) {
        u32x4 raw[8];
#pragma unroll
        for (int rr = 0; rr < 8; ++rr) raw[rr] = *(const u32x4*)(zgm + (size_t)(row0 + wid * 16 + hb * 8 + rr) * 1024 + 512 + 8 * lane);
        float v[8][8], s[8];
#pragma unroll
        for (int rr = 0; rr < 8; ++rr) { v[rr][0] = bf2f(raw[rr].x & 0xffffu); v[rr][1] = bf2f(raw[rr].x >> 16); v[rr][2] = bf2f(raw[rr].y & 0xffffu); v[rr][3] = bf2f(raw[rr].y >> 16); v[rr][4] = bf2f(raw[rr].z & 0xffffu); v[rr][5] = bf2f(raw[rr].z >> 16); v[rr][6] = bf2f(raw[rr].w & 0xffffu); v[rr][7] = bf2f(raw[rr].w >> 16);
            s[rr] = ((v[rr][0] + v[rr][1]) + (v[rr][2] + v[rr][3])) + ((v[rr][4] + v[rr][5]) + (v[rr][6] + v[rr][7])); }
#pragma unroll
        for (int rr = 0; rr < 8; ++rr) s[rr] = wave_sum(s[rr]) * (1.f / 512.f);
#pragma unroll
        for (int rr = 0; rr < 8; ++rr) { float q = 0.f;
#pragma unroll
            for (int i = 0; i < 8; ++i) { v[rr][i] -= s[rr]; q += v[rr][i] * v[rr][i]; }
            s[rr] = q; }
#pragma unroll
        for (int rr = 0; rr < 8; ++rr) s[rr] = rsqrtf(wave_sum(s[rr]) * (1.f / 512.f) + EPSN);
        if ((lane >> 5) == hf) {
#pragma unroll
            for (int rr = 0; rr < 8; ++rr) { const int q = wid * 16 + hb * 8 + rr;
#pragma unroll
                for (int i = 0; i < 8; ++i) vT[(8 * (lane & 31) + i) * 136 + q] = f2bf(v[rr][i] * s[rr] * g8[i] + b8[i]); } }
    }
    __syncthreads();
    const int r32 = lane & 31, hi = lane >> 5;
#pragma unroll 1
    for (int bi = 0; bi < 4; ++bi) { const int blk = wid + 8 * bi, gi = blk >> 3, pb = (blk >> 1) & 3, db = blk & 1; const int g = 4 * hf + gi;
        const float* wsrc = p.in[I_GWS] + ((size_t)(l * 8 + g) * 128 + 32 * pb + r32) * 128 + 8 * hi;
        const int ch = 256 * hf + 64 * gi + 32 * db + r32;
        float bsv[16]; bf16 uu[16], gg[16];
#pragma unroll
        for (int r = 0; r < 16; ++r) { const int pp = 32 * pb + crow(r, hi); const size_t row = (size_t)row0 + pp; bsv[r] = p.in[I_GBS][(l * 8 + g) * 128 + pp]; uu[r] = zgm[row * 1024 + ch]; gg[r] = gc[row * 512 + ch]; }
        f32x4 a0[8], a1[8];
#pragma unroll
        for (int ks = 0; ks < 8; ++ks) { a0[ks] = *(const f32x4*)(wsrc + 16 * ks); a1[ks] = *(const f32x4*)(wsrc + 16 * ks + 4); }
        f32x16 acc;
#pragma unroll
        for (int r = 0; r < 16; ++r) acc[r] = 0.f;
#pragma unroll
        for (int ks = 0; ks < 8; ++ks) {
            u32x4 aw; aw.x = pg8::cvt_pk_bf16(a0[ks][0], a0[ks][1]); aw.y = pg8::cvt_pk_bf16(a0[ks][2], a0[ks][3]); aw.z = pg8::cvt_pk_bf16(a1[ks][0], a1[ks][1]); aw.w = pg8::cvt_pk_bf16(a1[ks][2], a1[ks][3]);
            const bf16x8 bfr = *(const bf16x8*)(vT + (64 * gi + 32 * db + r32) * 136 + 16 * ks + 8 * hi);
            acc = __builtin_amdgcn_mfma_f32_32x32x16_bf16(__builtin_bit_cast(bf16x8, aw), bfr, acc, 0, 0, 0); }
#pragma unroll
        for (int r = 0; r < 16; ++r) { const int pp = 32 * pb + crow(r, hi); const size_t row = (size_t)row0 + pp;
            gated[row * 1536 + ch] = f2bf(bf2f(uu[r]) * (acc[r] + bsv[r]) * bf2f(gg[r])); } }
    __syncthreads();
}
template <bool MERGE> __device__ __forceinline__ void ctx_mini_gemm(const Params& p, unsigned char* lds, int wid0) {
    MK_TIDS(wid0)
    unsigned char* ws = p.ws;
    const int r32 = lane & 31, hi = lane >> 5;
    float* part = (float*)lds;
    for (int tile = blockIdx.x; tile < 256; tile += gridDim.x) {
        const int rb = tile >> 4, cb = tile & 15; const size_t arow = (size_t)MLAT + 32 * rb + r32;
        f32x16 tot[2];
#pragma unroll
        for (int c2 = 0; c2 < 2; ++c2)
#pragma unroll
            for (int r = 0; r < 16; ++r) tot[c2][r] = 0.f;
        if (MERGE) {
            const bf16* A = (const bf16*)(ws + WS_GATED) + arow * 1536 + 64 * wid + 8 * hi; const bf16* B = (const bf16*)(ws + WS_WBR) + (size_t)(64 * cb + r32) * 1536 + 64 * wid + 8 * hi;
            const bf16* sel = (const bf16*)(ws + WS_SEL);
#pragma unroll
            for (int i = 0; i < 3; ++i) { f32x16 acc[2];
#pragma unroll
                for (int c2 = 0; c2 < 2; ++c2)
#pragma unroll
                    for (int r = 0; r < 16; ++r) acc[c2][r] = 0.f;
#pragma unroll
                for (int ks = 0; ks < 4; ++ks) { const bf16x8 a = *(const bf16x8*)(A + i * 512 + 16 * ks), b0 = *(const bf16x8*)(B + i * 512 + 16 * ks), b1 = *(const bf16x8*)(B + (size_t)32 * 1536 + i * 512 + 16 * ks);
                    acc[0] = __builtin_amdgcn_mfma_f32_32x32x16_bf16(a, b0, acc[0], 0, 0, 0); acc[1] = __builtin_amdgcn_mfma_f32_32x32x16_bf16(a, b1, acc[1], 0, 0, 0); }
#pragma unroll
                for (int c2 = 0; c2 < 2; ++c2)
#pragma unroll
                    for (int r = 0; r < 16; ++r) tot[c2][r] += acc[c2][r] * bf2f(sel[((size_t)MLAT + 32 * rb + crow(r, hi)) * 3072 + i * 1024 + 64 * cb + 32 * c2 + r32]); }
        } else {
            const bf16* A = (const bf16*)(ws + WS_OUTPRE) + arow * 1024 + 128 * wid + 8 * hi; const bf16* B = (const bf16*)(ws + WS_WOUT) + (size_t)(64 * cb + r32) * 1024 + 128 * wid + 8 * hi;
#pragma unroll
            for (int ks = 0; ks < 8; ++ks) { const bf16x8 a = *(const bf16x8*)(A + 16 * ks), b0 = *(const bf16x8*)(B + 16 * ks), b1 = *(const bf16x8*)(B + (size_t)32 * 1024 + 16 * ks);
                tot[0] = __builtin_amdgcn_mfma_f32_32x32x16_bf16(a, b0, tot[0], 0, 0, 0); tot[1] = __builtin_amdgcn_mfma_f32_32x32x16_bf16(a, b1, tot[1], 0, 0, 0); }
        }
#pragma unroll
        for (int c2 = 0; c2 < 2; ++c2)
#pragma unroll
            for (int r = 0; r < 16; ++r) part[(wid * 32 + crow(r, hi)) * 64 + 32 * c2 + r32] = tot[c2][r];
        __syncthreads();
        { const int e = 4 * tid, rr = e >> 6, cc = e & 63; f32x4 sum = *(const f32x4*)(part + e);
#pragma unroll
          for (int w = 1; w < 8; ++w) sum = sum + *(const f32x4*)(part + w * 2048 + e);
          const size_t row = (size_t)MLAT + 32 * rb + rr; const int col = 64 * cb + cc;
          if (MERGE) { u32x2 o; o.x = pg8::cvt_pk_bf16(sum[0], sum[1]); o.y = pg8::cvt_pk_bf16(sum[2], sum[3]); *(u32x2*)((bf16*)(ws + WS_OUTPRE) + row * 1024 + col) = o; }
          else { u32x2 o; o.x = pg8::cvt_pk_bf16(sum[0], sum[1]); o.y = pg8::cvt_pk_bf16(sum[2], sum[3]); *(u32x2*)((bf16*)(ws + WS_OUT) + row * 1024 + col) = o; } }
        __syncthreads();
    }
}
#define XB_TMO      128
#define XB_XCNT(j)  (256  + 64 * (j))
#define XB_XSUB(j)  (1280 + 64 * (j))
#define XB_XGEN(j)  (2304 + 64 * (j))
#define XB_TOP      3328
#define XB_TOPGEN   3392
#define XCD_BAR_WORDS 3456
#define XB_SPIN_CAP (1u << 18)

__device__ __forceinline__ unsigned xb_ld(unsigned* p)              { return __hip_atomic_load(p, __ATOMIC_RELAXED, __HIP_MEMORY_SCOPE_AGENT); }
__device__ __forceinline__ unsigned xb_add(unsigned* p, unsigned v) { return __hip_atomic_fetch_add(p, v, __ATOMIC_RELAXED, __HIP_MEMORY_SCOPE_AGENT); }
__device__ __forceinline__ unsigned xb_xcc_id() { return (unsigned)__builtin_amdgcn_s_getreg((3 << 11) | 20) & 0xFu; }
#define XB_SPIN(cond, bar) do { unsigned _sp = 0; while (cond) { __builtin_amdgcn_s_sleep(1); \
    if ((++_sp & 255u) == 0u) { if (xb_ld(&(bar)[XB_TMO])) break; if (_sp > XB_SPIN_CAP) { atomicAdd(&(bar)[XB_TMO], 1u); break; } } } } while (0)

struct XcdBarrier {
    unsigned* bar; unsigned x;
    volatile LAS unsigned* st;
};

__device__ __forceinline__ XcdBarrier xcd_barrier_post(unsigned* bar, volatile LAS unsigned* st) {
    XcdBarrier b; b.bar = bar; b.x = xb_xcc_id(); b.st = st;
    if (threadIdx.x == 0) (void)xb_add(&bar[XB_XCNT(b.x)], 1u);
    return b;
}
__device__ __forceinline__ void xcd_barrier_complete(unsigned* bar, unsigned x, unsigned& nloc, unsigned& nx) {
    const unsigned G = gridDim.x * gridDim.y * gridDim.z;
    unsigned sum, cnt, mine, sp = 0u;
    for (;;) {
        sum = 0u; cnt = 0u; mine = 0u;
#pragma unroll
        for (unsigned j = 0; j < 16; ++j) { const unsigned c = xb_ld(&bar[XB_XCNT(j)]); sum += c; cnt += (c > 0u) ? 1u : 0u; mine = (j == x) ? c : mine; }
        if (sum == G) break;
        __builtin_amdgcn_s_sleep(1);
        if ((++sp & 255u) == 0u) { if (xb_ld(&bar[XB_TMO])) break; if (sp > XB_SPIN_CAP) { atomicAdd(&bar[XB_TMO], 1u); break; } }
    }
    nloc = mine > 0u ? mine : 1u; nx = cnt > 0u ? cnt : 1u;
}

__device__ __forceinline__ void xcd_barrier(const XcdBarrier& b) {
    asm volatile("s_waitcnt vmcnt(0)" ::: "memory");
    __syncthreads();
    if (threadIdx.x == 0) {
        unsigned* bar = b.bar;
        __builtin_amdgcn_s_waitcnt(0);
        unsigned nloc = b.st[0], nx = b.st[1];
        if (nloc == 0u) { xcd_barrier_complete(bar, b.x, nloc, nx); b.st[0] = nloc; b.st[1] = nx; }
        const unsigned old = xb_add(&bar[XB_XSUB(b.x)], 1u);
        const unsigned gen = old / nloc;
        if (old + 1u == (gen + 1u) * nloc) {
            __builtin_amdgcn_fence(__ATOMIC_RELEASE, "agent");
            asm volatile("s_waitcnt vmcnt(0)" ::: "memory");
            const unsigned og = xb_add(&bar[XB_TOP], 1u);
            const unsigned tg = og / nx;
            if (og + 1u == (tg + 1u) * nx) xb_add(&bar[XB_TOPGEN], 1u);
            else XB_SPIN(xb_ld(&bar[XB_TOPGEN]) == tg, bar);
            __builtin_amdgcn_fence(__ATOMIC_ACQUIRE, "agent");
            xb_add(&bar[XB_XGEN(b.x)], 1u);
            asm volatile("s_waitcnt vmcnt(0)" ::: "memory");
        } else {
            XB_SPIN(xb_ld(&bar[XB_XGEN(b.x)]) == gen, bar);
            __builtin_amdgcn_fence(__ATOMIC_ACQUIRE, "agent");
            asm volatile("s_waitcnt vmcnt(0)" ::: "memory");
        }
    }
    __syncthreads();
}

__device__ __forceinline__ void phaseC(const Params& p, int l, unsigned char* lds, int wid0) {
    int lane; asm volatile("v_mbcnt_lo_u32_b32 %0, -1, 0\n\tv_mbcnt_hi_u32_b32 %0, -1, %0" : "=v"(lane));
    const bool last = (l == DEPTH - 1);
    const float lam_init = 0.8f - 0.6f * expf(-0.3f * (float)l);
    float lam;
    { const float* lp = p.in[I_LAM] + l * 256; const float s1 = wave_sum(lp[lane] * lp[64 + lane]), s2 = wave_sum(lp[128 + lane] * lp[192 + lane]); lam = expf(s1) - expf(s2) + lam_init; }
    const int G = gridDim.x, bx = blockIdx.x;
#ifndef NO_ATT
    for (int rep = 0; rep < REP_ATT; ++rep)
    { const int nun = last ? 64 : 66;
      const int xg = (G % 8 == 0) ? 8 : 1, xi = bx % xg, ji = bx / xg, jn = G / xg;
      for (int bh = xi; bh < 8; bh += xg)
        for (int qb = ji; qb < nun; qb += jn) {
            const int b = bh >> 2, h = bh & 3; int qpos0, kbeg, nkt, grow0;
            if (qb < 64) { qpos0 = qb * 128; kbeg = 0; nkt = KEYS / 64; grow0 = b * SEQ + qb * 128; }
            else { qpos0 = SEQ + (qb - 64) * 128; kbeg = SEQ; nkt = CTXL / 64; grow0 = MLAT + b * CTXL + (qb - 64) * 128; }
            attn_unit(p, l, b, h, qpos0, kbeg, nkt, grow0, lam, lam_init, lds, wid0); } }
#endif
#ifndef NO_HY
    for (int rep = 0; rep < REP_HY; ++rep)
    for (int k = bx; k < 512; k += G) { const int c = (G == 256) ? (64 * (k & 7) + 32 * (k >> 8) + ((k & 255) >> 3)) : k;     hyena_channel(p, l, c, lds, wid0); }
#endif
#ifndef NO_HYC
    if (!last) for (int k = bx; k < 512; k += G) { const int it = (G == 256) ? ((k & 256) + 32 * (k & 7) + (((k & 255) >> 3) & 15) + 16 * ((k & 255) >> 7)) : k; hyena_ctx_pair(p, l, 2 * it, lds, wid0); }
#endif
#ifndef NO_GM
    for (int rep = 0; rep < REP_GM; ++rep)
    for (int it = bx; it < 256; it += G) gmlp_item(p, l, (it >> 1) * 128, it & 1, lds, wid0);
    if (!last) for (int it = (bx >= 128 ? bx - 128 : bx + G - 128); it < 8; it += G) gmlp_item(p, l, MLAT + (it >> 1) * 128, it & 1, lds, wid0);
#endif
}
__device__ __forceinline__ void phaseB(const Params& p, int l, unsigned char* lds, int wid0) {
    unsigned char* ws = p.ws;
    pg8::Gemm g{(const bf16*)(ws + WS_H), (const bf16*)(ws + WS_WIN), MROWS, NCOL, 1024}; pg8::StaticOrder S; S.init(MROWS, NCOL, gridDim.x, blockIdx.x);
    EpiIn E; E.K = (bf16*)(ws + WS_K); E.Q = (bf16*)(ws + WS_Q); E.Vt = (bf16*)(ws + WS_VT); E.ga = (bf16*)(ws + WS_GA); E.gc = (bf16*)(ws + WS_GC); E.zgm = (bf16*)(ws + WS_ZGM); E.sel = (bf16*)(ws + WS_SEL);
    E.zhyT = (bf16*)(ws + WS_ZHYT); E.zhyTc = (bf16*)(ws + WS_ZHYTC); E.gbT = (bf16*)(ws + WS_GBT); E.gbTc = (bf16*)(ws + WS_GBTC); E.rope = (const float*)(ws + WS_ROPE); E.kmax = (unsigned*)(ws + WS_CTL) + l * 32; E.last = (l == DEPTH - 1);
    pg8::gemm_phase<EpiIn, pg8::StaticOrder, true, true>((PG8_LAS unsigned char*)lds, g, S, E, mk_tid(wid0));
}
__device__ __forceinline__ void phaseD(const Params& p, int l, unsigned char* lds, int wid0) {
    unsigned char* ws = p.ws; const int M = MLAT;
    pg8::StaticOrder S; S.init(M, 1024, gridDim.x, blockIdx.x);
    pg8::Gemm g{(const bf16*)(ws + WS_GATED), (const bf16*)(ws + WS_WBR), M, 1024, 1536};
    EpiMergeF E{(const bf16*)(ws + WS_SEL), (bf16*)(ws + WS_OUTPRE)}; MergeHook H{(const bf16*)(ws + WS_SEL)};
    pg8::gemm_phase<EpiMergeF, pg8::StaticOrder, true, true, MergeHook>((PG8_LAS unsigned char*)lds, g, S, E, mk_tid(wid0), H);
    if (l < DEPTH - 1) { __syncthreads(); ctx_mini_gemm<true>(p, lds, wid0); }
}
__device__ __forceinline__ void phaseE(const Params& p, int l, unsigned char* lds, int wid0) {
    unsigned char* ws = p.ws;
    const int M = MLAT;
    pg8::Gemm g{(const bf16*)(ws + WS_OUTPRE), (const bf16*)(ws + WS_WOUT), M, 1024, 1024}; pg8::StaticOrder S; S.init(M, 1024, gridDim.x, blockIdx.x);
    EpiOut E{(bf16*)(ws + WS_OUT), (l == DEPTH - 1)};
    pg8::gemm_phase<EpiOut, pg8::StaticOrder, true, true>((PG8_LAS unsigned char*)lds, g, S, E, mk_tid(wid0));
    if (l < DEPTH - 1) { __syncthreads(); ctx_mini_gemm<false>(p, lds, wid0); }
}

__global__ void __launch_bounds__(512, 2) mk_fwd(Params p) {
    extern __shared__ __attribute__((aligned(16))) unsigned char lds[];
    const int wid0 = __builtin_amdgcn_readfirstlane(threadIdx.x >> 6);
    volatile LAS unsigned* bst = (volatile LAS unsigned*)((LAS unsigned char*)lds + LDS_BYTES - 64);
    if (threadIdx.x < 2) bst[threadIdx.x] = 0u;
    __syncthreads();
    XcdBarrier bar; bar.bar = (unsigned*)(p.ws + WS_BAR); bar.x = 0; bar.st = bst;
    if (p.ph_hi - p.ph_lo > 1) bar = xcd_barrier_post((unsigned*)(p.ws + WS_BAR), bst);
    for (int ph = p.ph_lo; ph < p.ph_hi; ++ph) {
        if (ph == p.ph_lo + 1) cg::this_grid().sync();
        else if (ph > p.ph_lo) for (int rep = 0; rep < REP_SYNC; ++rep) xcd_barrier(bar);
#ifndef NO_0
        if (ph == 0) { phase0(p, wid0); __syncthreads();
            for (int it = blockIdx.x; it < 24; it += gridDim.x) filter_item(p, it >> 3, CTXL, 32 * (it & 7), (float*)(p.ws + WS_FILTC) + (size_t)(it >> 3) * 262144, (float*)(lds + 104448), wid0);
            continue; }
#endif
#ifndef NO_A
        if (ph == NPHASE - 1) { phaseA(p, DEPTH, lds, wid0); continue; }
#endif
        const int l = (ph - 1) / 5, s = (ph - 1) % 5;
#ifndef NO_A
        if (s == 0) phaseA(p, l, lds, wid0);
#endif
#ifndef NO_B
        if (s == 1) for (int rep = 0; rep < REP_B; ++rep) phaseB(p, l, lds, wid0);
#endif
#ifndef NO_C
        if (s == 2) phaseC(p, l, lds, wid0);
#endif
#ifndef NO_D
        if (s == 3) for (int rep = 0; rep < REP_DE; ++rep) phaseD(p, l, lds, wid0);
#endif
#ifndef NO_E
        if (s == 4) for (int rep = 0; rep < REP_DE; ++rep) phaseE(p, l, lds, wid0);
#endif
        __syncthreads();
    }
}

extern "C" void kernel_launch(void* const* d_in, const int* in_sizes, int n_in, void* d_out, int out_size, void* d_ws, size_t ws_size, hipStream_t stream) {
    static int grid = 0;
    if (grid == 0) {
        if (n_in != 26 || out_size != MLAT * DM || ws_size < WS_END) { fprintf(stderr, "kernel_launch: unexpected shapes / workspace (n_in %d out %d ws %zu)\n", n_in, out_size, ws_size); grid = -1; }
        else {
            int dev = 0, cus = 0, per_cu = 0;
            hipGetDevice(&dev); hipDeviceGetAttribute(&cus, hipDeviceAttributeMultiprocessorCount, dev);
            hipFuncSetAttribute((const void*)mk_fwd, hipFuncAttributeMaxDynamicSharedMemorySize, LDS_BYTES);
            hipOccupancyMaxActiveBlocksPerMultiprocessor(&per_cu, (const void*)mk_fwd, 512, LDS_BYTES);
            (void)hipGetLastError();
            if (per_cu < 1) per_cu = 1;
            grid = cus;
        }
    }
    if (grid < 0) { hipMemsetAsync(d_out, 0, (size_t)out_size * 4, stream); return; }
    hipMemsetAsync((char*)d_ws + WS_BAR, 0, XCD_BAR_WORDS * 4, stream);
    Params p{};
    for (int i = 0; i < 26; ++i) p.in[i] = (const float*)d_in[i];
    p.out = (float*)d_out; p.ws = (unsigned char*)d_ws;
#if MK_ONE_LAUNCH
    p.ph_lo = 0; p.ph_hi = NPHASE;
    void* args[] = {&p};
    hipError_t e = hipLaunchCooperativeKernel((const void*)mk_fwd, dim3(grid), dim3(512), args, LDS_BYTES, stream);
    if (e != hipSuccess) fprintf(stderr, "cooperative launch failed: %s (grid %d)\n", hipGetErrorString(e), grid);
#else
    for (int ph = 0; ph < NPHASE; ++ph) { p.ph_lo = ph; p.ph_hi = ph + 1; hipLaunchKernelGGL(mk_fwd, dim3(grid), dim3(512), LDS_BYTES, stream, p); }
#endif
}
```

```cpp
#include <hip/hip_runtime.h>
#include <hip/hip_cooperative_groups.h>
#include <cstdio>
#include <cstdint>
#include <cmath>
namespace cg = cooperative_groups;
namespace pg8 {
#define PG8_LAS __attribute__((address_space(3)))
typedef unsigned short bf16_t;
typedef short bf16x8 __attribute__((ext_vector_type(8)));
typedef float f32x4 __attribute__((ext_vector_type(4)));
typedef unsigned u32x4 __attribute__((ext_vector_type(4)));
constexpr int BM = 256, BK = 64, HALF = 128, HTB = HALF * BK * 2  , STAGE_BYTES = 8 * HTB, NXCD = 8, WGM = 8;

__host__ __device__ __forceinline__ int lds_byte(int r, int c) { const int st = (r >> 4) * 2 + (c >> 5), rr = r & 15, cc = c & 31, ob = rr * 64 + cc * 2; return st * 1024 + (ob ^ (((ob >> 9) & 1) << 5)); }
__host__ __device__ __forceinline__ void stage_rc(int b, int& R, int& C) { const int st = b / 1024, sb = b % 1024, swz = sb ^ (((sb >> 9) & 1) << 5); R = (st >> 1) * 16 + swz / 64; C = (st & 1) * 32 + (swz % 64) / 2; }
__host__ __device__ __forceinline__ int perm32(int rho) { const int n = rho >> 4, i = rho & 15; return 8 * (i >> 2) + 4 * n + (i & 3); }

struct Unit { int pm, pn; };
struct Gemm { const bf16_t* A; const bf16_t* Bt; int M, N, K; };

struct StaticOrder {
    int nM, nN, nwg, G, c;
    __host__ __device__ void init(int M, int N, int G_, int c_) { nM = M / BM; nN = N / BM; nwg = nM * nN; G = G_; c = c_; }
    __host__ __device__ bool next(int i, Unit& u) const {
        const long L = (long)i * G + c; if (L >= nwg) return false;
        int wgid = (int)L; { const int q = nwg / NXCD, r = nwg % NXCD, xcd = wgid % NXCD, off = wgid / NXCD; wgid = (xcd < r ? xcd * (q + 1) : r * (q + 1) + (xcd - r) * q) + off; }
        const int nig = WGM * nN, gid = wgid / nig, fm = gid * WGM, gsz = (nM - fm) < WGM ? (nM - fm) : WGM;
        u.pm = fm + ((wgid % nig) % gsz); u.pn = (wgid % nig) / gsz; return true;
    }
    __device__ __forceinline__ void a_ready(const Unit&) const {}
    __device__ __forceinline__ void done(const Unit&) const {}
};

__device__ __forceinline__ unsigned cvt_pk_bf16(float lo, float hi) { unsigned r; asm volatile("v_cvt_pk_bf16_f32 %0, %1, %2" : "=v"(r) : "v"(lo), "v"(hi)); return r; }
typedef float f32x2 __attribute__((ext_vector_type(2)));
__device__ __forceinline__ f32x2 gelu_pk(f32x2 v) {
    const f32x2 av = __builtin_elementwise_abs(v), d = av * 0.2316418882f + 1.0f;
    f32x2 t; t.x = __builtin_amdgcn_rcpf(d.x); t.y = __builtin_amdgcn_rcpf(d.y);
    f32x2 q = t * 0.5307027145f + (-0.7265760135f); q = q * t + 0.7107068705f; q = q * t + (-0.142248368f); q = q * t + 0.127414796f; q = q * t;
    const f32x2 s = (v * v) * (-0.72134752044f);
    f32x2 e; e.x = __builtin_amdgcn_exp2f(s.x); e.y = __builtin_amdgcn_exp2f(s.y);
    const f32x2 m = v * (q * e), r = v - m;
    f32x2 o; o.x = v.x < 0.f ? m.x : r.x; o.y = v.y < 0.f ? m.y : r.y; return o;
}

struct NoHook { static constexpr bool ON = false; template <class A> __device__ __forceinline__ void operator()(A&, const Unit&, int, int, int, int, int) const {} };
template <class Epi, class Sched, bool ALIGN_EPI = false, bool SP2 = false, class Hook = NoHook>
__device__ __forceinline__ void gemm_phase(PG8_LAS unsigned char* lds, const Gemm g, const Sched& S, const Epi& E, int tid, const Hook& H = Hook()) {
    const int wid = __builtin_amdgcn_readfirstlane(tid >> 6), lane = tid & 63, wr = wid >> 2, wc = wid & 3, fr = lane & 15, fq = lane >> 4;
    const int K = g.K, nt = K / BK;
    unsigned voffA[2], voffB[2];
#pragma unroll
    for (int i = 0; i < 2; ++i) { int R, C; stage_rc(tid * 16 + i * 8192, R, C); const int Rb = Epi::PERM ? ((R & ~31) + perm32(R & 31)) : R;
        voffA[i] = (unsigned)(R * K + C) * 2u; voffB[i] = (unsigned)(Rb * K + C) * 2u; }
    const size_t kstep = (size_t)(BK * 2);
    const size_t hstep = (size_t)HALF * K * 2;
    const size_t tstep = 2 * hstep;
    const unsigned ldsw = (unsigned)wid * 1024u;
    const int aoff = lds_byte(wr * 64 + fr, fq * 8), boff = lds_byte(wc * 32 + fr, fq * 8);
#define PG8_SA(b, h) (((b) * 2 + (h)) * HTB)
#define PG8_SB(b, h) ((4 + (b) * 2 + (h)) * HTB)
#define PG8_STAGE(bufoff, gbase, voff) do { _Pragma("unroll") for (int _i = 0; _i < 2; ++_i) \
        __builtin_amdgcn_global_load_lds((const unsigned*)((const char*)(gbase) + (voff)[_i]), (PG8_LAS unsigned*)(lds + (bufoff) + ldsw + _i * 8192), 16, 0, 0); } while (0)
#define PG8_LDA(dst, b, h) do { _Pragma("unroll") for (int m = 0; m < 4; ++m) _Pragma("unroll") for (int k = 0; k < 2; ++k) dst[m][k] = *(const PG8_LAS bf16x8*)(lds + PG8_SA(b, h) + aoff + m * 2048 + k * 1024); } while (0)
#define PG8_LDB(dst, b, h) do { _Pragma("unroll") for (int n = 0; n < 2; ++n) _Pragma("unroll") for (int k = 0; k < 2; ++k) dst[n][k] = *(const PG8_LAS bf16x8*)(lds + PG8_SB(b, h) + boff + n * 2048 + k * 1024); } while (0)
#define PG8_MMA(ai, bj, At, Bt) do { __builtin_amdgcn_s_setprio(1); _Pragma("unroll") for (int m = 0; m < 4; ++m) _Pragma("unroll") for (int n = 0; n < 2; ++n) _Pragma("unroll") for (int k = 0; k < 2; ++k) \
        acc[ai][bj][m][n] = __builtin_amdgcn_mfma_f32_16x16x32_bf16(Bt[n][k], At[m][k], acc[ai][bj][m][n], 0, 0, 0); __builtin_amdgcn_s_setprio(0); } while (0)
#define PG8_WAIT_V(n) asm volatile("s_waitcnt vmcnt(" #n ")" ::: "memory")
#define PG8_WAIT_L(n) asm volatile("s_waitcnt lgkmcnt(" #n ")" ::: "memory")
#define PG8_BAR __builtin_amdgcn_s_barrier()
#define PG8_SCHED __builtin_amdgcn_sched_barrier(0)
    Unit cur, nxt; int ui = 0;
    if (!S.next(0, cur)) return;
    f32x4 acc[2][2][4][2];
#pragma unroll
    for (int a = 0; a < 2; ++a)
#pragma unroll
        for (int b = 0; b < 2; ++b)
#pragma unroll
            for (int m = 0; m < 4; ++m)
#pragma unroll
                for (int n = 0; n < 2; ++n) acc[a][b][m][n] = (f32x4){0.f, 0.f, 0.f, 0.f};
    bf16x8 At[4][2], B0[2][2], B1[2][2];
    const char* cA = (const char*)g.A + (size_t)cur.pm * tstep; const char* cB = (const char*)g.Bt + (size_t)cur.pn * tstep;
    S.a_ready(cur);
    if constexpr (SP2) {
        PG8_STAGE(PG8_SB(0, 0), cB, voffB); PG8_STAGE(PG8_SB(0, 1), cB + hstep, voffB); PG8_STAGE(PG8_SA(0, 0), cA, voffA); PG8_STAGE(PG8_SA(0, 1), cA + hstep, voffA);
        if (wr == 1) PG8_BAR;
        PG8_WAIT_V(2); PG8_BAR;
        PG8_STAGE(PG8_SB(1, 0), cB + kstep, voffB); PG8_STAGE(PG8_SA(1, 0), cA + kstep, voffA); PG8_STAGE(PG8_SB(1, 1), cB + hstep + kstep, voffB);
        PG8_WAIT_V(6); PG8_BAR;
    } else {
        PG8_STAGE(PG8_SB(0, 0), cB, voffB); PG8_STAGE(PG8_SA(0, 0), cA, voffA); PG8_STAGE(PG8_SB(0, 1), cB + hstep, voffB); PG8_STAGE(PG8_SA(0, 1), cA + hstep, voffA);
        if (wr == 1) PG8_BAR;
        PG8_WAIT_V(4); PG8_BAR;
        PG8_STAGE(PG8_SB(1, 0), cB + kstep, voffB); PG8_STAGE(PG8_SA(1, 0), cA + kstep, voffA); PG8_STAGE(PG8_SB(1, 1), cB + hstep + kstep, voffB);
        PG8_WAIT_V(6); PG8_BAR;
    }
    for (;;) {
        const bool has_next = S.next(ui + 1, nxt);
        const char* nA = has_next ? (const char*)g.A + (size_t)nxt.pm * tstep : cA; const char* nB = has_next ? (const char*)g.Bt + (size_t)nxt.pn * tstep : cB;
        for (int t = 0; t < nt; t += 2) {
            if constexpr (Hook::ON) { if (t == 8 || t == 16) H(acc, cur, wr, wc, fr, fq, t); }
            const bool last = (t == nt - 2);
            const char* a1 = cA + (size_t)(t + 1) * kstep;
            const char* a2 = last ? nA : cA + (size_t)(t + 2) * kstep; const char* b2 = last ? nB : cB + (size_t)(t + 2) * kstep;
            const char* a3 = a2 + kstep; const char* b3 = b2 + kstep;
            if (last && has_next) S.a_ready(nxt);
            if constexpr (SP2) {
            PG8_LDB(B0, 0, 0); PG8_LDB(B1, 0, 1); PG8_SCHED; PG8_LDA(At, 0, 0); PG8_STAGE(PG8_SA(1, 1), a1 + hstep, voffA);
            PG8_WAIT_V(8); PG8_WAIT_L(0); PG8_BAR; PG8_MMA(0, 0, At, B0); PG8_MMA(0, 1, At, B1); PG8_BAR; PG8_SCHED;
            PG8_LDA(At, 0, 1); PG8_STAGE(PG8_SB(0, 0), b2, voffB); PG8_STAGE(PG8_SB(0, 1), b2 + hstep, voffB); PG8_STAGE(PG8_SA(0, 0), a2, voffA);
            PG8_WAIT_V(8); PG8_WAIT_L(0); PG8_BAR; PG8_MMA(1, 0, At, B0); PG8_MMA(1, 1, At, B1); PG8_BAR; PG8_SCHED;
            PG8_LDB(B0, 1, 0); PG8_LDB(B1, 1, 1); PG8_SCHED; PG8_LDA(At, 1, 0); PG8_STAGE(PG8_SA(0, 1), a2 + hstep, voffA);
            PG8_WAIT_V(8); PG8_WAIT_L(0); PG8_BAR; PG8_MMA(0, 0, At, B0); PG8_MMA(0, 1, At, B1); PG8_BAR; PG8_SCHED;
            PG8_LDA(At, 1, 1); PG8_STAGE(PG8_SB(1, 0), b3, voffB); PG8_STAGE(PG8_SB(1, 1), b3 + hstep, voffB); PG8_STAGE(PG8_SA(1, 0), a3, voffA);
            PG8_WAIT_V(8); PG8_WAIT_L(0); PG8_BAR; PG8_MMA(1, 0, At, B0); PG8_MMA(1, 1, At, B1); PG8_BAR; PG8_SCHED;
            } else {
            PG8_LDB(B0, 0, 0); PG8_SCHED; PG8_LDA(At, 0, 0); PG8_STAGE(PG8_SA(1, 1), a1 + hstep, voffA);
            PG8_WAIT_L(8); PG8_BAR; PG8_WAIT_L(0); PG8_MMA(0, 0, At, B0); PG8_BAR; PG8_SCHED;
            PG8_LDB(B1, 0, 1); PG8_STAGE(PG8_SB(0, 0), b2, voffB);
            PG8_BAR; PG8_WAIT_L(0); PG8_MMA(0, 1, At, B1); PG8_BAR;
            PG8_LDA(At, 0, 1); PG8_STAGE(PG8_SA(0, 0), a2, voffA);
            PG8_BAR; PG8_WAIT_L(0); PG8_MMA(1, 0, At, B0); PG8_BAR; PG8_SCHED;
            PG8_STAGE(PG8_SB(0, 1), b2 + hstep, voffB);
            PG8_WAIT_V(6); PG8_BAR; PG8_MMA(1, 1, At, B1); PG8_BAR;
            PG8_LDB(B0, 1, 0); PG8_SCHED; PG8_LDA(At, 1, 0); PG8_STAGE(PG8_SA(0, 1), a2 + hstep, voffA);
            PG8_WAIT_L(8); PG8_BAR; PG8_WAIT_L(0); PG8_MMA(0, 0, At, B0); PG8_BAR; PG8_SCHED;
            PG8_LDB(B1, 1, 1); PG8_STAGE(PG8_SB(1, 0), b3, voffB);
            PG8_BAR; PG8_WAIT_L(0); PG8_MMA(0, 1, At, B1); PG8_BAR;
            PG8_LDA(At, 1, 1); PG8_STAGE(PG8_SA(1, 0), a3, voffA);
            PG8_BAR; PG8_WAIT_L(0); PG8_MMA(1, 0, At, B0); PG8_BAR; PG8_SCHED;
            PG8_STAGE(PG8_SB(1, 1), b3 + hstep, voffB);
            PG8_WAIT_V(6); PG8_BAR; PG8_MMA(1, 1, At, B1); PG8_BAR;
            }
        }
        if constexpr (ALIGN_EPI) { if (wr == 0) PG8_BAR; }
        if constexpr (!Epi::AFTER_DRAIN) { E(acc, cur, wr, wc, fr, fq); S.done(cur); }
        if (!has_next) break;
#pragma unroll
        for (int a = 0; a < 2; ++a)
#pragma unroll
            for (int b = 0; b < 2; ++b)
#pragma unroll
                for (int m = 0; m < 4; ++m)
#pragma unroll
                    for (int n = 0; n < 2; ++n) acc[a][b][m][n] = (f32x4){0.f, 0.f, 0.f, 0.f};
        cur = nxt; cA = nA; cB = nB; ++ui;
        if constexpr (ALIGN_EPI) { if (wr == 1) PG8_BAR; }
    }
    PG8_WAIT_V(0);
    if constexpr (!ALIGN_EPI) { if (wr == 0) PG8_BAR; }
    PG8_BAR;
    if constexpr (Epi::AFTER_DRAIN) { E.fused(acc, cur, wr, wc, fr, fq, lds, wid, lane); S.done(cur); }
#undef PG8_SA
#undef PG8_SB
#undef PG8_STAGE
#undef PG8_LDA
#undef PG8_LDB
#undef PG8_MMA
#undef PG8_WAIT_V
#undef PG8_WAIT_L
#undef PG8_BAR
#undef PG8_SCHED
}
}
#ifndef REP_B
#define REP_B 1
#endif
#ifndef REP_ATT
#define REP_ATT 1
#endif
#ifndef REP_HY
#define REP_HY 1
#endif
#ifndef REP_GM
#define REP_GM 1
#endif
#ifndef REP_DE
#define REP_DE 1
#endif
#ifndef REP_A2
#define REP_A2 1
#endif
#ifndef REP_SYNC
#define REP_SYNC 1
#endif
#ifndef MK_ONE_LAUNCH
#define MK_ONE_LAUNCH 1
#endif
#define LAS __attribute__((address_space(3)))
typedef unsigned short bf16;
typedef float f32x4 __attribute__((ext_vector_type(4)));
typedef float f32x2 __attribute__((ext_vector_type(2)));
typedef float f32x16 __attribute__((ext_vector_type(16)));
typedef short bf16x8 __attribute__((ext_vector_type(8)));
typedef unsigned u32x2 __attribute__((ext_vector_type(2)));
typedef unsigned u32x4 __attribute__((ext_vector_type(4)));

constexpr int DM = 1024, SEQ = 8192, CTXL = 256, MROWS = 16896, MLAT = 16384, NCOL = 8704, KEYS = 8448, DEPTH = 4;
constexpr float EPSN = 1e-6f;
constexpr float QSCALE = 0.125f * 1.4426950408889634f;
constexpr size_t MiB = 1u << 20;
constexpr size_t WS_CTL = 0, WS_BAR = 65536, WS_MODP = 1 * MiB, WS_ROPE = 3 * MiB, WS_XC = 4 * MiB, WS_WIN = 8 * MiB, WS_WBR = 25 * MiB, WS_WOUT = 28 * MiB,
    WS_H = 32 * MiB, WS_K = 66 * MiB, WS_Q = 83 * MiB, WS_VT = 100 * MiB, WS_GA = 117 * MiB, WS_GC = 134 * MiB, WS_ZGM = 151 * MiB, WS_SEL = 184 * MiB,
    WS_ZHYT = 283 * MiB, WS_ZHYTC = 331 * MiB, WS_GBT = 333 * MiB, WS_GBTC = 349 * MiB, WS_GATED = 350 * MiB, WS_FILT = 400 * MiB, WS_FILTC = 432 * MiB  , WS_END = 436 * MiB;
constexpr size_t WS_OUTPRE = WS_H, WS_OUT = WS_SEL, WS_TMP = WS_ZHYT;
constexpr size_t GATED_STRIDE = (size_t)MROWS * 512;
constexpr int LDS_BYTES = 147456;
constexpr int NPHASE = 22;

struct Params { const float* in[26]; float* out; unsigned char* ws; int ph_lo, ph_hi; };
enum { I_X = 0, I_C, I_CTX, I_CCTX, I_ADAW, I_ADAB, I_NPRE, I_NPOST, I_WIN, I_LAM, I_SUBLN, I_SW, I_SB, I_FW1, I_FB1, I_FW2, I_FB2, I_FW3, I_FFREQ, I_HBIAS, I_LNG, I_LNB, I_GWS, I_GBS, I_WBR, I_WOUT };

#define MK_TIDS(w0) int tid; asm volatile("v_mbcnt_lo_u32_b32 %0, -1, 0\n\tv_mbcnt_hi_u32_b32 %0, -1, %0" : "=v"(tid)); const int lane = tid; tid += (w0) * 64; const int wid = (w0);
__device__ __forceinline__ int mk_tid(int w0) { int t; asm volatile("v_mbcnt_lo_u32_b32 %0, -1, 0\n\tv_mbcnt_hi_u32_b32 %0, -1, %0" : "=v"(t)); return t + w0 * 64; }
__device__ __forceinline__ float bf2f(unsigned b) { return __uint_as_float(b << 16); }
__device__ __forceinline__ bf16 f2bf(float v) { return (bf16)(pg8::cvt_pk_bf16(v, 0.f) & 0xffffu); }
__device__ __forceinline__ float wave_sum(float v) {
#pragma unroll
    for (int o = 1; o < 64; o <<= 1) v += __shfl_xor(v, o);
    return v;
}
__device__ __forceinline__ float silu_f(float x) { return x * __builtin_amdgcn_rcpf(1.f + __expf(-x)); }
__device__ __forceinline__ float sigm_f(float x) { return __builtin_amdgcn_rcpf(1.f + __expf(-x)); }
__device__ __forceinline__ int crow(int r, int hi) { return (r & 3) + 8 * (r >> 2) + 4 * hi; }

struct EpiIn {
    static constexpr bool PERM = false, AFTER_DRAIN = false;
    bf16 *K, *Q, *Vt, *ga, *gc, *zgm, *sel, *zhyT, *zhyTc, *gbT, *gbTc; const float* rope; unsigned* kmax; int last;
    template <int ACT> __device__ __forceinline__ static float act(float v) { if (ACT == 1) return silu_f(v); if (ACT == 3) return sigm_f(v); return v; }
    template <int ACT> __device__ __forceinline__ void rowmajor(const f32x4 (&acc)[2][2][4][2], bf16* dst, int ld, int colbase, int row0, int wc, int fq) const {
#pragma unroll
        for (int ai = 0; ai < 2; ++ai)
#pragma unroll
            for (int m = 0; m < 4; ++m) { bf16* rowp = dst + (size_t)(row0 + ai * 128 + m * 16) * ld + colbase + wc * 32 + 4 * fq;
#pragma unroll
                for (int bj = 0; bj < 2; ++bj)
#pragma unroll
                    for (int n = 0; n < 2; ++n) { f32x4 v = acc[ai][bj][m][n];
                        if (ACT == 2) { f32x2 a = pg8::gelu_pk((f32x2){v[0], v[1]}), b = pg8::gelu_pk((f32x2){v[2], v[3]}); v = (f32x4){a.x, a.y, b.x, b.y}; }
                        else { v[0] = act<ACT>(v[0]); v[1] = act<ACT>(v[1]); v[2] = act<ACT>(v[2]); v[3] = act<ACT>(v[3]); }
                        u32x2 w; w.x = pg8::cvt_pk_bf16(v[0], v[1]); w.y = pg8::cvt_pk_bf16(v[2], v[3]); *(u32x2*)(rowp + bj * 128 + n * 16) = w; } }
    }
    template <int ACT> __device__ __forceinline__ void transposed(const f32x4 (&acc)[2][2][4][2], bf16* dstT, int LT, int colbase, int t0, int wc, int fq) const {
#pragma unroll
        for (int ai = 0; ai < 2; ++ai)
#pragma unroll
            for (int m = 0; m < 4; ++m) { const int t = t0 + ai * 128 + m * 16;
#pragma unroll
                for (int bj = 0; bj < 2; ++bj)
#pragma unroll
                    for (int n = 0; n < 2; ++n) { const f32x4 v = acc[ai][bj][m][n]; const int col = colbase + bj * 128 + wc * 32 + n * 16 + 4 * fq;
#pragma unroll
                        for (int i = 0; i < 4; ++i) dstT[(size_t)(col + i) * LT + t] = f2bf(act<ACT>(v[i])); } }
    }
    __device__ __forceinline__ void operator()(const f32x4 (&acc)[2][2][4][2], const pg8::Unit& u, int wr, int wc, int fr, int fq) const {
        asm volatile("" : "+v"(fr), "+v"(fq));
        const int pm = u.pm, pn = u.pn;
        const bool isctx = pm >= 64; const int b = isctx ? pm - 64 : (pm >> 5); const int t0 = (isctx ? 0 : (pm & 31) * 256) + wr * 64 + fr;
        const int row0 = pm * 256 + wr * 64 + fr;
        if (isctx && last && pn >= 4) return;
        if (pn < 2 || (pn >= 4 && pn < 6)) {
            const bool isq = pn >= 4; const int hp = isq ? pn - 4 : pn; const int map = wc >> 1, axis = wc & 1;
            bf16* dst = isq ? Q : K; float mx[2] = {0.f, 0.f};
#pragma unroll
            for (int ai = 0; ai < 2; ++ai)
#pragma unroll
                for (int m = 0; m < 4; ++m) { const int t = t0 + ai * 128 + m * 16; const int pos = isctx ? SEQ + t : t;
                    f32x4 cs = (f32x4){1.f, 1.f, 1.f, 1.f}, sn = (f32x4){0.f, 0.f, 0.f, 0.f};
                    if (!isctx) { const int pa = axis ? (t & 63) : (t >> 6); cs = *(const f32x4*)(rope + pa * 16 + 4 * fq); sn = *(const f32x4*)(rope + 2048 + pa * 16 + 4 * fq); }
#pragma unroll
                    for (int bj = 0; bj < 2; ++bj) { const int h = 2 * hp + bj; const f32x4 x1 = acc[ai][bj][m][0], x2 = acc[ai][bj][m][1];
                        f32x4 o1 = x1 * cs - x2 * sn, o2 = x2 * cs + x1 * sn;
                        if (isq) { o1 = o1 * QSCALE; o2 = o2 * QSCALE; }
                        else { float ss = (o1[0] * o1[0] + o1[1] * o1[1]) + (o1[2] * o1[2] + o1[3] * o1[3]) + (o2[0] * o2[0] + o2[1] * o2[1]) + (o2[2] * o2[2] + o2[3] * o2[3]);
                            ss += __shfl_xor(ss, 16); ss += __shfl_xor(ss, 32); mx[bj] = fmaxf(mx[bj], ss); }
                        u32x2 w1, w2; w1.x = pg8::cvt_pk_bf16(o1[0], o1[1]); w1.y = pg8::cvt_pk_bf16(o1[2], o1[3]); w2.x = pg8::cvt_pk_bf16(o2[0], o2[1]); w2.y = pg8::cvt_pk_bf16(o2[2], o2[3]);
                        if (isq) { bf16* rowp = dst + ((size_t)((b * 4 + h) * 2 + map) * KEYS + pos) * 64 + 32 * axis + 4 * fq; *(u32x2*)rowp = w1; *(u32x2*)(rowp + 16) = w2; }
                        else {
                            bf16* rowp = dst + (((((size_t)(b * 4 + h) * 132 + (pos >> 6)) * 2 + map) * 8 + 4 * axis + (fq >> 1)) * 64 + (pos & 63)) * 8 + 4 * (fq & 1);
                            *(u32x2*)rowp = w1; *(u32x2*)(rowp + 2 * 512) = w2; } } }
            if (!isq) {
#pragma unroll
                for (int bj = 0; bj < 2; ++bj) { float mm = mx[bj]; mm = fmaxf(mm, __shfl_xor(mm, 1)); mm = fmaxf(mm, __shfl_xor(mm, 2)); mm = fmaxf(mm, __shfl_xor(mm, 4)); mm = fmaxf(mm, __shfl_xor(mm, 8));
                    if (fr == 0 && fq == 0) atomicMax(kmax + ((b * 4 + 2 * hp + bj) * 2 + map) * 2 + axis, __float_as_uint(mm)); }
            }
        } else if (pn < 4) {
#pragma unroll
            for (int ai = 0; ai < 2; ++ai)
#pragma unroll
                for (int m = 0; m < 4; ++m) { const int t = t0 + ai * 128 + m * 16; const int pos = isctx ? SEQ + t : t;
                    const int pp = (pos & ~12) | ((pos & 4) << 1) | ((pos & 8) >> 1);
#pragma unroll
                    for (int bj = 0; bj < 2; ++bj) { const int h = 2 * (pn - 2) + bj;
#pragma unroll
                        for (int n = 0; n < 2; ++n) { const f32x4 v = acc[ai][bj][m][n]; const int d = wc * 32 + n * 16 + 4 * fq;
#pragma unroll
                            for (int i = 0; i < 4; ++i) Vt[((((size_t)(b * 4 + h) * 132 + (pp >> 6)) * 8 + ((pp & 63) >> 3)) * 128 + d + i) * 8 + (pp & 7)] = f2bf(v[i]); } } }
        } else if (pn < 8) { rowmajor<1>(acc, ga, 512, (pn - 6) * 256, row0, wc, fq);
        } else if (pn < 14) { if (isctx) transposed<0>(acc, zhyTc + (size_t)b * 1536 * CTXL, CTXL, (pn - 8) * 256, t0, wc, fq); else transposed<0>(acc, zhyT + (size_t)b * 1536 * SEQ, SEQ, (pn - 8) * 256, t0, wc, fq);
        } else if (pn < 16) { if (isctx) transposed<1>(acc, gbTc + (size_t)b * 512 * CTXL, CTXL, (pn - 14) * 256, t0, wc, fq); else transposed<1>(acc, gbT + (size_t)b * 512 * SEQ, SEQ, (pn - 14) * 256, t0, wc, fq);
        } else if (pn < 20) { rowmajor<2>(acc, zgm, 1024, (pn - 16) * 256, row0, wc, fq);
        } else if (pn < 22) { rowmajor<1>(acc, gc, 512, (pn - 20) * 256, row0, wc, fq);
        } else { rowmajor<3>(acc, sel, 3072, (pn - 22) * 256, row0, wc, fq); }
    }
};
struct MergeHook {
    static constexpr bool ON = true; const bf16* sel;
    __device__ __forceinline__ void operator()(f32x4 (&acc)[2][2][4][2], const pg8::Unit& u, int wr, int wc, int fr, int fq, int t) const {
        asm volatile("" : "+v"(fr), "+v"(fq));
        const int i = t >> 3;
        const int row0 = u.pm * 256 + wr * 64 + fr, col0 = u.pn * 256 + wc * 32 + 4 * fq;
#pragma unroll
        for (int ai = 0; ai < 2; ++ai)
#pragma unroll
            for (int m = 0; m < 4; ++m) { const bf16* sp = sel + (size_t)(row0 + ai * 128 + m * 16) * 3072 + (i - 1) * 1024 + col0;
#pragma unroll
                for (int bj = 0; bj < 2; ++bj)
#pragma unroll
                    for (int n = 0; n < 2; ++n) { const u32x2 a = *(const u32x2*)(sp + bj * 128 + n * 16), b = *(const u32x2*)(sp + 1024 + bj * 128 + n * 16);
                        f32x4 r; r[0] = bf2f(a.x & 0xffffu) * __builtin_amdgcn_rcpf(fmaxf(bf2f(b.x & 0xffffu), 1e-30f)); r[1] = bf2f(a.x >> 16) * __builtin_amdgcn_rcpf(fmaxf(bf2f(b.x >> 16), 1e-30f));
                        r[2] = bf2f(a.y & 0xffffu) * __builtin_amdgcn_rcpf(fmaxf(bf2f(b.y & 0xffffu), 1e-30f)); r[3] = bf2f(a.y >> 16) * __builtin_amdgcn_rcpf(fmaxf(bf2f(b.y >> 16), 1e-30f));
                        acc[ai][bj][m][n] = acc[ai][bj][m][n] * r; }
                asm volatile("" ::: "memory"); }
    }
};
struct EpiMergeF {
    static constexpr bool PERM = false, AFTER_DRAIN = false;
    const bf16* sel; bf16* outpre;
    __device__ __forceinline__ void operator()(const f32x4 (&acc)[2][2][4][2], const pg8::Unit& u, int wr, int wc, int fr, int fq) const {
        asm volatile("" : "+v"(fr), "+v"(fq));
        const int row0 = u.pm * 256 + wr * 64 + fr, col0 = u.pn * 256 + wc * 32 + 4 * fq;
#pragma unroll
        for (int ai = 0; ai < 2; ++ai)
#pragma unroll
            for (int m = 0; m < 4; ++m) { const size_t row = row0 + ai * 128 + m * 16;
#pragma unroll
                for (int bj = 0; bj < 2; ++bj)
#pragma unroll
                    for (int n = 0; n < 2; ++n) { const int col = col0 + bj * 128 + n * 16;
                        const u32x2 sr = *(const u32x2*)(sel + row * 3072 + 2048 + col);
                        f32x4 v = acc[ai][bj][m][n]; v[0] *= bf2f(sr.x & 0xffffu); v[1] *= bf2f(sr.x >> 16); v[2] *= bf2f(sr.y & 0xffffu); v[3] *= bf2f(sr.y >> 16);
                        u32x2 w; w.x = pg8::cvt_pk_bf16(v[0], v[1]); w.y = pg8::cvt_pk_bf16(v[2], v[3]); *(u32x2*)(outpre + row * 1024 + col) = w; } }
    }
};
struct EpiOut {
    static constexpr bool PERM = false, AFTER_DRAIN = false;
    bf16* out; int last;
    __device__ __forceinline__ void operator()(const f32x4 (&acc)[2][2][4][2], const pg8::Unit& u, int wr, int wc, int fr, int fq) const {
        if (u.pm >= 64 && last) return;
        asm volatile("" : "+v"(fr), "+v"(fq));
        const int row0 = u.pm * 256 + wr * 64 + fr, col0 = u.pn * 256 + wc * 32 + 4 * fq;
#pragma unroll
        for (int ai = 0; ai < 2; ++ai)
#pragma unroll
            for (int m = 0; m < 4; ++m)
#pragma unroll
                for (int bj = 0; bj < 2; ++bj)
#pragma unroll
                    for (int n = 0; n < 2; ++n) { const f32x4 v = acc[ai][bj][m][n]; u32x2 w; w.x = pg8::cvt_pk_bf16(v[0], v[1]); w.y = pg8::cvt_pk_bf16(v[2], v[3]); *(u32x2*)(out + (size_t)(row0 + ai * 128 + m * 16) * 1024 + col0 + bj * 128 + n * 16) = w; }
    }
};
__device__ __forceinline__ void phase0(const Params& p, int wid0) {
    MK_TIDS(wid0)
    unsigned char* ws = p.ws;
    if (blockIdx.x == 0 && tid < 128) ((unsigned*)(ws + WS_CTL))[tid] = 0u;
    { const int gid = blockIdx.x * 512 + tid;
      if (gid < 2048) { const int pa = gid >> 4, f = gid & 15; const float inv = exp2f(-(float)f * (13.287712379549449f / 16.f)); const float ang = (float)pa * inv;
          float* rope = (float*)(ws + WS_ROPE); rope[gid] = cosf(ang); rope[2048 + gid] = sinf(ang); } }
    const int gw = blockIdx.x * 8 + wid, NGW = gridDim.x * 8;
    float* modp = (float*)(ws + WS_MODP);
    for (int it = gw; it < DEPTH * 48 * 8; it += NGW) {
        const int kc = it & 7, cb = (it >> 3) % 48, l = it / (48 * 8); const int col = cb * 64 + lane;
        float sv[3][2];
#pragma unroll
        for (int j = 0; j < 2; ++j) { const int k = kc * 128 + j * 64 + lane;
            sv[0][j] = silu_f(p.in[I_C][k]); sv[1][j] = silu_f(p.in[I_C][1024 + k]); sv[2][j] = silu_f(p.in[I_CCTX][k]); }
        float a0 = 0.f, a1 = 0.f, a2 = 0.f;
        const float* W = p.in[I_ADAW] + ((size_t)l * 1024 + kc * 128) * 3072 + col;
#pragma unroll
        for (int j = 0; j < 2; ++j)
#pragma unroll 16
            for (int kk = 0; kk < 64; ++kk) { const float w = W[(size_t)(j * 64 + kk) * 3072];
                a0 += __shfl(sv[0][j], kk) * w; a1 += __shfl(sv[1][j], kk) * w; a2 += __shfl(sv[2][j], kk) * w; }
        if (kc == 0) { const float bb = p.in[I_ADAB][l * 3072 + col]; a0 += bb; a1 += bb; a2 += bb; }
        float* o = modp + ((size_t)(kc * DEPTH + l) * 3) * 3072 + col;
        o[0] = a0; o[3072] = a1; o[6144] = a2;
    }
}

__device__ __forceinline__ void transpose_item(const float* W, int K, int N, bf16* WT, int ldt, float* scr, int item, int lane) {
    const int nblk = N / 32, kb = item / nblk, nb = item % nblk, k0 = 64 * kb, n0 = 32 * nb;
#pragma unroll 8
    for (int i = 0; i < 32; ++i) { const int kk = 2 * i + (lane >> 5); scr[kk * 33 + (lane & 31)] = W[(size_t)(k0 + kk) * N + n0 + (lane & 31)]; }
    __builtin_amdgcn_s_waitcnt(0); asm volatile("" ::: "memory");
    const int c = lane & 7;
#pragma unroll
    for (int j = 0; j < 4; ++j) { const int n = (lane >> 3) + 8 * j; const float* s = scr + (8 * c) * 33 + n;
        u32x4 o; o.x = pg8::cvt_pk_bf16(s[0 * 33], s[1 * 33]); o.y = pg8::cvt_pk_bf16(s[2 * 33], s[3 * 33]); o.z = pg8::cvt_pk_bf16(s[4 * 33], s[5 * 33]); o.w = pg8::cvt_pk_bf16(s[6 * 33], s[7 * 33]);
        *(u32x4*)(WT + (size_t)(n0 + n) * ldt + k0 + 8 * c) = o; }
    __builtin_amdgcn_s_waitcnt(0); asm volatile("" ::: "memory");
}
__device__ __forceinline__ void filter_item(const Params& p, int l, int Lf, int t0, float* dst, float* hidT  , int wid0) {
    MK_TIDS(wid0)
    const float* w1 = p.in[I_FW1] + l * 33 * 64; const float* b1 = p.in[I_FB1] + l * 64; const float* w2 = p.in[I_FW2] + l * 64 * 64; const float* b2 = p.in[I_FB2] + l * 64;
    const float* w3 = p.in[I_FW3] + (size_t)l * 64 * 1024; const float* fq = p.in[I_FFREQ] + l * 128;
    const float f0 = fq[lane], f1 = fq[64 + lane], bb1 = b1[lane], bb2 = b2[lane];
    float* w1s = hidT + 2048; float* w2s = w1s + 33 * 64;
    { float t1[5], t2[8];
#pragma unroll
      for (int k = 0; k < 5; ++k) { const int idx = tid + 512 * k; t1[k] = idx < 33 * 64 ? w1[idx] : 0.f; }
#pragma unroll
      for (int k = 0; k < 8; ++k) t2[k] = w2[tid + 512 * k];
#pragma unroll
      for (int k = 0; k < 5; ++k) { const int idx = tid + 512 * k; if (idx < 33 * 64) w1s[idx] = t1[k]; }
#pragma unroll
      for (int k = 0; k < 8; ++k) w2s[tid + 512 * k] = t2[k]; }
    __syncthreads();
    { float z[4], a[4], c[4];
#pragma unroll
      for (int pp = 0; pp < 4; ++pp) { const int t = t0 + 4 * wid + pp;
        const float tn = (float)t / (float)(Lf - 1); const float wpos = (6.283185307179586f / (float)Lf) * (float)t;
        float zz = 0.f;
        if (lane == 0) zz = tn;
        else if (lane <= 16) { const float band = 1e-4f + (float)(lane - 1) * ((15.f - 1e-4f) / 15.f); zz = cosf(band * wpos); }
        else if (lane <= 32) { const float band = 1e-4f + (float)(lane - 17) * ((15.f - 1e-4f) / 15.f); zz = -sinf(band * wpos); }
        z[pp] = zz; a[pp] = bb1; c[pp] = bb2; }
#pragma unroll 3
      for (int e = 0; e < 33; ++e) { const float w = w1s[e * 64 + lane];
#pragma unroll
        for (int pp = 0; pp < 4; ++pp) a[pp] += __shfl(z[pp], e) * w; }
#pragma unroll
      for (int pp = 0; pp < 4; ++pp) a[pp] = sinf(f0 * a[pp]);
#pragma unroll 4
      for (int i = 0; i < 64; ++i) { const float w = w2s[i * 64 + lane];
#pragma unroll
        for (int pp = 0; pp < 4; ++pp) c[pp] += __shfl(a[pp], i) * w; }
#pragma unroll
      for (int pp = 0; pp < 4; ++pp) hidT[lane * 32 + 4 * wid + pp] = sinf(f1 * c[pp]); }
    __syncthreads();
    float acc0[32], acc1[32];
#pragma unroll
    for (int i = 0; i < 32; ++i) { acc0[i] = 0.f; acc1[i] = 0.f; }
#pragma unroll 16
    for (int j = 0; j < 64; ++j) {
        const float wa = w3[j * 1024 + tid], wb = w3[j * 1024 + 512 + tid];
#pragma unroll
        for (int g = 0; g < 8; ++g) { const f32x4 hv = *(const f32x4*)(hidT + j * 32 + 4 * g);
#pragma unroll
            for (int i = 0; i < 4; ++i) { acc0[4 * g + i] += hv[i] * wa; acc1[4 * g + i] += hv[i] * wb; } }
    }
    const float dmin = -3.0701134573253945f, dmax = -15.350567286626973f;
    const float delta = fabsf(dmin + (float)tid * ((dmax - dmin) / 511.f));
#pragma unroll
    for (int g = 0; g < 8; ++g) { f32x4 o0, o1;
#pragma unroll
        for (int i = 0; i < 4; ++i) { const float tn = (float)(t0 + 4 * g + i) / (float)(Lf - 1); const float wdw = __expf(-tn * delta); o0[i] = acc0[4 * g + i] * wdw; o1[i] = acc1[4 * g + i] * wdw; }
        *(f32x4*)(dst + (size_t)tid * Lf + t0 + 4 * g) = o0; *(f32x4*)(dst + (size_t)(512 + tid) * Lf + t0 + 4 * g) = o1; }
    __syncthreads();
}
__device__ __forceinline__ void phaseA(const Params& p, int l, unsigned char* lds, int wid0) {
    MK_TIDS(wid0)
    unsigned char* ws = p.ws;
    float* vA = (float*)lds; float* vSH = vA + 3072; float* vGTP = vSH + 3072;
    const float* modp = (const float*)(ws + WS_MODP);
    for (int idx = tid; idx < 3072; idx += 512) { const int cond = idx >> 10, col = idx & 1023;
        if (l < DEPTH) { float sh = 0.f, sc = 0.f;
#pragma unroll
            for (int kc = 0; kc < 8; ++kc) { const float* o = modp + ((size_t)(kc * DEPTH + l) * 3 + cond) * 3072; sh += o[col]; sc += o[1024 + col]; }
            vA[idx] = p.in[I_NPRE][l * 1024 + col] * (1.f + sc); vSH[idx] = sh; }
        if (l > 0) { float gt = 0.f;
#pragma unroll
            for (int kc = 0; kc < 8; ++kc) gt += modp[((size_t)(kc * DEPTH + (l - 1)) * 3 + cond) * 3072 + 2048 + col];
            vGTP[idx] = gt * p.in[I_NPOST][(l - 1) * 1024 + col]; } }
    __syncthreads();
    const int gw = blockIdx.x * 8 + wid, NGW = gridDim.x * 8;
    const bf16* outb = (const bf16*)(ws + WS_OUT); bf16* hb = (bf16*)(ws + WS_H); float* xc = (float*)(ws + WS_XC);
    const int nrows = (l < DEPTH) ? MROWS : MLAT;
    for (int r0 = gw; r0 < nrows; r0 += 2 * NGW) {
        const int r1 = r0 + NGW; const bool two = r1 < nrows;
        f32x4 v[2][4], o[2][4]; const float* xs[2]; float* xd[2]; int cond[2]; int rr[2] = {r0, two ? r1 : r0};
#pragma unroll
        for (int k = 0; k < 2; ++k) { const int r = rr[k]; const bool isctx = r >= MLAT; cond[k] = isctx ? 2 : (r >> 13);
            if (!isctx) { xs[k] = (l <= 1 ? p.in[I_X] : p.out) + (size_t)r * 1024; xd[k] = p.out + (size_t)r * 1024; }
            else { xs[k] = (l <= 1 ? p.in[I_CTX] : xc) + (size_t)(r - MLAT) * 1024; xd[k] = xc + (size_t)(r - MLAT) * 1024; }
#pragma unroll
            for (int j = 0; j < 4; ++j) v[k][j] = *(const f32x4*)(xs[k] + 4 * lane + 256 * j);
            if (l > 0) {
#pragma unroll
                for (int j = 0; j < 4; ++j) { const u32x2 w = *(const u32x2*)(outb + (size_t)r * 1024 + 4 * lane + 256 * j); o[k][j] = (f32x4){bf2f(w.x & 0xffffu), bf2f(w.x >> 16), bf2f(w.y & 0xffffu), bf2f(w.y >> 16)}; } } }
        if (l > 0) { float ss[2];
#pragma unroll
            for (int k = 0; k < 2; ++k) { ss[k] = 0.f;
#pragma unroll
                for (int j = 0; j < 4; ++j) ss[k] += (o[k][j][0] * o[k][j][0] + o[k][j][1] * o[k][j][1]) + (o[k][j][2] * o[k][j][2] + o[k][j][3] * o[k][j][3]); }
            ss[0] = wave_sum(ss[0]); ss[1] = wave_sum(ss[1]);
#pragma unroll
            for (int k = 0; k < 2; ++k) { const float rinv = rsqrtf(ss[k] * (1.f / 1024.f) + EPSN);
                if (k == 0 || two) {
#pragma unroll
                    for (int j = 0; j < 4; ++j) { const f32x4 g = *(const f32x4*)(vGTP + cond[k] * 1024 + 4 * lane + 256 * j); v[k][j] = v[k][j] + g * o[k][j] * rinv; *(f32x4*)(xd[k] + 4 * lane + 256 * j) = v[k][j]; } } } }
        if (l < DEPTH) { float ss[2];
#pragma unroll
            for (int k = 0; k < 2; ++k) { ss[k] = 0.f;
#pragma unroll
                for (int j = 0; j < 4; ++j) ss[k] += (v[k][j][0] * v[k][j][0] + v[k][j][1] * v[k][j][1]) + (v[k][j][2] * v[k][j][2] + v[k][j][3] * v[k][j][3]); }
            ss[0] = wave_sum(ss[0]); ss[1] = wave_sum(ss[1]);
#pragma unroll
            for (int k = 0; k < 2; ++k) { const float rinv = rsqrtf(ss[k] * (1.f / 1024.f) + EPSN);
                if (k == 0 || two) {
#pragma unroll
                    for (int j = 0; j < 4; ++j) { const f32x4 a = *(const f32x4*)(vA + cond[k] * 1024 + 4 * lane + 256 * j), sh = *(const f32x4*)(vSH + cond[k] * 1024 + 4 * lane + 256 * j);
                        const f32x4 h = v[k][j] * rinv * a + sh; u32x2 w; w.x = pg8::cvt_pk_bf16(h[0], h[1]); w.y = pg8::cvt_pk_bf16(h[2], h[3]); *(u32x2*)(hb + (size_t)rr[k] * 1024 + 4 * lane + 256 * j) = w; } } } }
    }
    if (l >= DEPTH) return;
    for (int rep = 0; rep < REP_A2; ++rep) {
    { float* scr = (float*)(lds + 36864 + wid * 8448);
      constexpr int I_IN = 16 * 272, I_BR = 8 * 32, I_O = 16 * 32;
      for (int it = gw; it < I_IN + 3 * I_BR + I_O; it += NGW) { int r = it;
          if (r < I_IN) { transpose_item(p.in[I_WIN] + (size_t)l * 1024 * NCOL, 1024, NCOL, (bf16*)(ws + WS_WIN), 1024, scr, r, lane); continue; } r -= I_IN;
          if (r < 3 * I_BR) { const int i = r / I_BR; transpose_item(p.in[I_WBR] + ((size_t)l * 3 + i) * 512 * 1024, 512, 1024, (bf16*)(ws + WS_WBR) + (size_t)i * 512, 1536, scr, r % I_BR, lane); continue; } r -= 3 * I_BR;
          transpose_item(p.in[I_WOUT] + (size_t)l * 1024 * 1024, 1024, 1024, (bf16*)(ws + WS_WOUT), 1024, scr, r, lane); } }
    { float* hidT = (float*)(lds + 104448);
      for (int it = blockIdx.x; it < 256; it += gridDim.x) filter_item(p, l, SEQ, 32 * it, (float*)(ws + WS_FILT), hidT, wid0);
      }
    __syncthreads();
    }
}
__device__ __forceinline__ float sumsq8(bf16x8 v) { float s = 0.f;
#pragma unroll
    for (int j = 0; j < 8; ++j) { const float f = bf2f((unsigned)(unsigned short)v[j]); s += f * f; } return s; }
__device__ __forceinline__ bf16x8 pack8(const f32x16& S, int o) { u32x4 w; w.x = pg8::cvt_pk_bf16(S[o + 0], S[o + 1]); w.y = pg8::cvt_pk_bf16(S[o + 2], S[o + 3]); w.z = pg8::cvt_pk_bf16(S[o + 4], S[o + 5]); w.w = pg8::cvt_pk_bf16(S[o + 6], S[o + 7]); return __builtin_bit_cast(bf16x8, w); }
__device__ __forceinline__ void attn_unit(const Params& p, int l, int b, int h, int qpos0, int kbeg, int nkt, int grow0, float lam, float lam_init, unsigned char* lds, int wid0) {
    MK_TIDS(wid0)
    unsigned char* ws = p.ws;
    const bf16* Q = (const bf16*)(ws + WS_Q); const bf16* K = (const bf16*)(ws + WS_K); const bf16* Vt = (const bf16*)(ws + WS_VT);
    const bf16* ga = (const bf16*)(ws + WS_GA); bf16* gated = (bf16*)(ws + WS_GATED);
    const unsigned* kmax = (const unsigned*)(ws + WS_CTL) + l * 32;
    const int r32 = lane & 31, hi = lane >> 5, bh = b * 4 + h, qg = wid >> 1, map = wid & 1;
    bf16x8 qf[4]; float Msh;
    f32x16 o[4];
#pragma unroll
    for (int db = 0; db < 4; ++db)
#pragma unroll
        for (int r = 0; r < 16; ++r) o[db][r] = 0.f;
    float lsum = 0.f;
    LAS unsigned char* ldsl = (LAS unsigned char*)lds;
    const bf16* kt_g = K + (size_t)bh * 132 * 8192 + (size_t)(2 * wid) * 512 + lane * 8; const bf16* vt_g = Vt + (size_t)bh * 132 * 8192 + (size_t)(2 * wid) * 512 + lane * 8;
#define AT_DMA(tile, buf) do { const bf16* kp_ = kt_g + (size_t)(tile) * 8192; const bf16* vp_ = vt_g + (size_t)(tile) * 8192; LAS unsigned char* lb_ = ldsl + (buf) * 32768 + (2 * wid) * 1024; \
        __builtin_amdgcn_global_load_lds((const unsigned*)kp_, (LAS unsigned*)lb_, 16, 0, 0); __builtin_amdgcn_global_load_lds((const unsigned*)(kp_ + 512), (LAS unsigned*)(lb_ + 1024), 16, 0, 0); \
        __builtin_amdgcn_global_load_lds((const unsigned*)vp_, (LAS unsigned*)(lb_ + 16384), 16, 0, 0); __builtin_amdgcn_global_load_lds((const unsigned*)(vp_ + 512), (LAS unsigned*)(lb_ + 16384 + 1024), 16, 0, 0); } while (0)
    const int kt0 = kbeg >> 6;
#define AT_LDK(bufoff, kbi) do { _Pragma("unroll") for (int s_ = 0; s_ < 4; ++s_) kf[s_] = *(const LAS bf16x8*)(kl_ + (bufoff) + ((2 * s_) * 64 + 32 * (kbi)) * 16); } while (0)
#define AT_LDV(bufoff, kbi) do { _Pragma("unroll") for (int db_ = 0; db_ < 4; ++db_) { vf[2 * db_] = *(const LAS bf16x8*)(vl_ + (bufoff) + ((4 * (kbi)) * 128 + 32 * db_) * 16); vf[2 * db_ + 1] = *(const LAS bf16x8*)(vl_ + (bufoff) + ((4 * (kbi) + 2) * 128 + 32 * db_) * 16); } } while (0)
#define AT_MQK(dst) do { dst = __builtin_amdgcn_mfma_f32_32x32x16_bf16(kf[0], qf[0], negm, 0, 0, 0); _Pragma("unroll") for (int s_ = 1; s_ < 4; ++s_) dst = __builtin_amdgcn_mfma_f32_32x32x16_bf16(kf[s_], qf[s_], dst, 0, 0, 0); } while (0)
#define AT_MPV(pk0_, pk1_) do { _Pragma("unroll") for (int db_ = 0; db_ < 4; ++db_) { o[db_] = __builtin_amdgcn_mfma_f32_32x32x16_bf16(pk0_, vf[2 * db_], o[db_], 0, 0, 0); o[db_] = __builtin_amdgcn_mfma_f32_32x32x16_bf16(pk1_, vf[2 * db_ + 1], o[db_], 0, 0, 0); } } while (0)
#define AT_SM(src, pk0_, pk1_) do { float ls_ = 0.f; _Pragma("unroll") for (int r_ = 0; r_ < 16; ++r_) { src[r_] = __builtin_amdgcn_exp2f(src[r_]); ls_ += src[r_]; } lsum += ls_; pk0_ = pack8(src, 0); pk1_ = pack8(src, 8); } while (0)
#define AT_SB() __builtin_amdgcn_sched_barrier(0)
    const LAS unsigned char* kl_ = ldsl + ((map * 8 + hi) * 64 + r32) * 16; const LAS unsigned char* vl_ = ldsl + 16384 + (hi * 128 + r32) * 16;
    AT_DMA(kt0, 0); if (nkt > 1) AT_DMA(kt0 + 1, 1); if (nkt > 2) AT_DMA(kt0 + 2, 2);
    { const bf16* qp = Q + ((size_t)(bh * 2 + map) * KEYS + qpos0 + qg * 32 + r32) * 64 + hi * 8;
#pragma unroll
        for (int s = 0; s < 4; ++s) qf[s] = *(const bf16x8*)(qp + 16 * s);
        float nA = sumsq8(qf[0]) + sumsq8(qf[1]), nB = sumsq8(qf[2]) + sumsq8(qf[3]);
        nA += __shfl_xor(nA, 32); nB += __shfl_xor(nB, 32);
        const float kA = __uint_as_float(kmax[(bh * 2 + map) * 2 + 0]), kB = __uint_as_float(kmax[(bh * 2 + map) * 2 + 1]);
        Msh = sqrtf(nA * kA) + sqrtf(nB * kB); }
    asm volatile("s_waitcnt vmcnt(0)" ::: "memory"); __syncthreads();
    f32x16 Sc, Sn, negm; bf16x8 kf[4], vf[8];
#pragma unroll
    for (int r = 0; r < 16; ++r) negm[r] = -Msh;
    asm volatile("" : "+v"(negm));
    AT_LDK(0, 0); AT_MQK(Sc);
    bf16x8 pA0, pA1, pB0, pB1;
#pragma unroll
    for (int j = 0; j < 8; ++j) { pA0[j] = 0; pA1[j] = 0; }
    int bop = 98304, bo = 0, bo1 = 32768, bo2 = 65536;
    for (int it = 0; it < nkt; ++it) {
        AT_LDK(bo, 1); AT_LDV((it ? bop : bo), 1); AT_SB();
        AT_SM(Sc, pB0, pB1); AT_SB();
        __builtin_amdgcn_s_setprio(1); AT_MQK(Sn); AT_MPV(pA0, pA1); __builtin_amdgcn_s_setprio(0); AT_SB();
        if (it + 2 < nkt) asm volatile("s_waitcnt vmcnt(4)" ::: "memory"); else asm volatile("s_waitcnt vmcnt(0)" ::: "memory");
        __syncthreads();
        if (it + 3 < nkt) AT_DMA(kt0 + it + 3, (bop >> 15));
        if (it + 1 < nkt) AT_LDK(bo1, 0);
        AT_LDV(bo, 0); AT_SB();
        AT_SM(Sn, pA0, pA1); AT_SB();
        __builtin_amdgcn_s_setprio(1); if (it + 1 < nkt) AT_MQK(Sc);
        AT_MPV(pB0, pB1); __builtin_amdgcn_s_setprio(0); AT_SB();
        const int tb = bop; bop = bo; bo = bo1; bo1 = bo2; bo2 = tb;
    }
    AT_LDV(bop, 1); AT_MPV(pA0, pA1);
    __syncthreads();
#undef AT_LDK
#undef AT_LDV
#undef AT_MQK
#undef AT_MPV
#undef AT_SM
#undef AT_SB
#undef AT_DMA
    lsum += __shfl_xor(lsum, 32);
    float* wsf = (float*)(lds + 131072) + wid * 32;
    if (hi == 0) wsf[r32] = (map == 0 ? 1.f : lam) / lsum;
    __builtin_amdgcn_s_waitcnt(0); asm volatile("" ::: "memory");
    float* xch = (float*)lds + qg * (32 * 132);
    if (map == 1) {
#pragma unroll
        for (int r = 0; r < 16; ++r) { const int q = crow(r, hi); const float c = wsf[q];
#pragma unroll
            for (int db = 0; db < 4; ++db) xch[q * 132 + 32 * db + r32] = o[db][r] * c; }
    }
    __syncthreads();
    if (map == 0) {
        const float* sg = p.in[I_SUBLN] + l * 128; float g4[4];
#pragma unroll
        for (int db = 0; db < 4; ++db) g4[db] = sg[32 * db + r32] * (1.f - lam_init);
        bf16 gv[16][4];
#pragma unroll
        for (int r = 0; r < 16; ++r) { const size_t grow = (size_t)grow0 + qg * 32 + crow(r, hi);
#pragma unroll
            for (int db = 0; db < 4; ++db) gv[r][db] = ga[grow * 512 + h * 128 + 32 * db + r32]; }
#pragma unroll
        for (int r = 0; r < 16; ++r) { const int q = crow(r, hi); const float a = wsf[q]; float v[4]; float ss = 0.f;
#pragma unroll
            for (int db = 0; db < 4; ++db) { v[db] = o[db][r] * a - xch[q * 132 + 32 * db + r32]; ss += v[db] * v[db]; }
            ss += __shfl_xor(ss, 1); ss += __shfl_xor(ss, 2); ss += __shfl_xor(ss, 4); ss += __shfl_xor(ss, 8); ss += __shfl_xor(ss, 16);
            const float rinv = rsqrtf(ss * (1.f / 128.f) + EPSN); const size_t grow = (size_t)grow0 + qg * 32 + q;
#pragma unroll
            for (int db = 0; db < 4; ++db) { const int col = h * 128 + 32 * db + r32; gated[grow * 1536 + col] = f2bf(v[db] * rinv * g4[db] * bf2f(gv[r][db])); } }
    }
    __syncthreads();
}

struct cf { float x, y; };
__device__ __forceinline__ cf cadd(cf a, cf b) { return {a.x + b.x, a.y + b.y}; }
__device__ __forceinline__ cf csub(cf a, cf b) { return {a.x - b.x, a.y - b.y}; }
__device__ __forceinline__ cf cmul(cf a, cf b) { return {a.x * b.x - a.y * b.y, a.x * b.y + a.y * b.x}; }
__device__ __forceinline__ cf cmulc(cf a, cf b) { return {a.x * b.x + a.y * b.y, a.y * b.x - a.x * b.y}; }
template <bool INV> __device__ __forceinline__ void dft4(cf& a0, cf& a1, cf& a2, cf& a3) {
    const cf t0 = cadd(a0, a2), t1 = csub(a0, a2), t2 = cadd(a1, a3), t3 = csub(a1, a3);
    a0 = cadd(t0, t2); a2 = csub(t0, t2);
    if (!INV) { a1 = {t1.x + t3.y, t1.y - t3.x}; a3 = {t1.x - t3.y, t1.y + t3.x}; }
    else      { a1 = {t1.x - t3.y, t1.y + t3.x}; a3 = {t1.x + t3.y, t1.y - t3.x}; }
}
#define W16C(m) ((m) == 0 ? 1.f : (m) == 1 ? 0.9238795325112867f : (m) == 2 ? 0.7071067811865476f : (m) == 3 ? 0.3826834323650898f : (m) == 4 ? 0.f : (m) == 6 ? -0.7071067811865476f : (m) == 9 ? -0.9238795325112867f : 0.f)
#define W16S(m) ((m) == 0 ? 0.f : (m) == 1 ? 0.3826834323650898f : (m) == 2 ? 0.7071067811865476f : (m) == 3 ? 0.9238795325112867f : (m) == 4 ? 1.f : (m) == 6 ? 0.7071067811865476f : (m) == 9 ? -0.3826834323650898f : 0.f)
template <bool INV> __device__ __forceinline__ void dft16(cf (&a)[16]) {
#pragma unroll
    for (int n2 = 0; n2 < 4; ++n2) dft4<INV>(a[n2], a[4 + n2], a[8 + n2], a[12 + n2]);
#pragma unroll
    for (int k1 = 1; k1 < 4; ++k1)
#pragma unroll
        for (int n2 = 1; n2 < 4; ++n2) { const cf w = {W16C(n2 * k1), W16S(n2 * k1)};
            a[4 * k1 + n2] = INV ? cmul(a[4 * k1 + n2], w) : cmulc(a[4 * k1 + n2], w); }
#pragma unroll
    for (int k1 = 0; k1 < 4; ++k1) dft4<INV>(a[4 * k1 + 0], a[4 * k1 + 1], a[4 * k1 + 2], a[4 * k1 + 3]);
}
__device__ __forceinline__ int fidx(int e) { return e + ((e >> 6) << 2); }
template <bool INV, int LQ> __device__ __forceinline__ void fft_pass16(f32x2* X, int tid) {
    constexpr int q = 1 << LQ, STR = q + 4 * (q >> 6);
#pragma unroll 1
    for (int gg = 0; gg < 2; ++gg) {
        const int g = tid + 512 * gg, blk = g >> LQ, i = g & (q - 1), base = (blk << (LQ + 4)) + i;
        f32x2* xb = X + fidx(base);
        cf a[16];
#pragma unroll
        for (int j = 0; j < 16; ++j) { const f32x2 v = xb[j * STR]; a[j] = {v.x, v.y}; }
        const float rev = (float)i * (1.f / (float)(16 << LQ));
        const cf w1 = {__builtin_amdgcn_cosf(rev), __builtin_amdgcn_sinf(rev)};
        if (!INV) {
            dft16<false>(a);
            cf w = w1;
#pragma unroll
            for (int k = 1; k < 16; ++k) { const int src = 4 * (k & 3) + (k >> 2);
                const cf y = cmulc(a[src], w); xb[k * STR] = (f32x2){y.x, y.y}; w = cmul(w, w1); }
            xb[0] = (f32x2){a[0].x, a[0].y};
        } else {
            cf w = w1;
#pragma unroll
            for (int k = 1; k < 16; ++k) { a[k] = cmul(a[k], w); w = cmul(w, w1); }
            dft16<true>(a);
#pragma unroll
            for (int k = 0; k < 16; ++k) { const int src = 4 * (k & 3) + (k >> 2); xb[k * STR] = (f32x2){a[src].x, a[src].y}; }
        }
    }
}
template <bool INV> __device__ __forceinline__ void fft_pass4(f32x2* X, int tid) {
#pragma unroll 4
    for (int gg = 0; gg < 8; ++gg) { const int g = tid + 512 * gg; f32x2* xp = X + fidx(4 * g);
        const f32x4 v01 = *(const f32x4*)xp, v23 = *(const f32x4*)(xp + 2);
        cf a0 = {v01[0], v01[1]}, a1 = {v01[2], v01[3]}, a2 = {v23[0], v23[1]}, a3 = {v23[2], v23[3]};
        dft4<INV>(a0, a1, a2, a3);
        *(f32x4*)xp = (f32x4){a0.x, a0.y, a1.x, a1.y}; *(f32x4*)(xp + 2) = (f32x4){a2.x, a2.y, a3.x, a3.y}; }
}
__device__ __forceinline__ float block_sum(float v, float* red, int lane, int wid) {
    v = wave_sum(v); __syncthreads(); if (lane == 0) red[wid] = v; __syncthreads();
    float s = 0.f;
#pragma unroll
    for (int i = 0; i < 8; ++i) s += red[i];
    return s;
}
__device__ __forceinline__ float zat(const bf16* z, int t, int L) { return (t >= 0 && t < L) ? bf2f(z[t]) : 0.f; }
__device__ __forceinline__ float sconv(const bf16* z, int t, int L, float w0, float w1, float w2, float bb) { return w0 * zat(z, t - 1, L) + w1 * zat(z, t, L) + w2 * zat(z, t + 1, L) + bb; }
__device__ __forceinline__ void ld10(const bf16* row, int t0, float (&o)[10]) {
    const u32x4 raw = *(const u32x4*)(row + t0);
    o[0] = t0 > 0 ? bf2f(row[t0 - 1]) : 0.f; o[9] = t0 + 8 < SEQ ? bf2f(row[t0 + 8]) : 0.f;
    o[1] = bf2f(raw.x & 0xffffu); o[2] = bf2f(raw.x >> 16); o[3] = bf2f(raw.y & 0xffffu); o[4] = bf2f(raw.y >> 16); o[5] = bf2f(raw.z & 0xffffu); o[6] = bf2f(raw.z >> 16); o[7] = bf2f(raw.w & 0xffffu); o[8] = bf2f(raw.w >> 16);
}
__device__ __forceinline__ void hyena_channel(const Params& p, int l, int c, unsigned char* lds, int wid0) {
    MK_TIDS(wid0)
    unsigned char* ws = p.ws;
    f32x2* X = (f32x2*)lds; float* red = (float*)(lds + 139264);
    const float* filt = (const float*)(ws + WS_FILT);
    const float* sw = p.in[I_SW] + l * 3 * 1536; const float* sb = p.in[I_SB] + l * 1536;
    const float w00 = sw[c], w01 = sw[1536 + c], w02 = sw[3072 + c], b0 = sb[c];
    const float w10 = sw[512 + c], w11 = sw[1536 + 512 + c], w12 = sw[3072 + 512 + c], b1 = sb[512 + c];
    const float w20 = sw[1024 + c], w21 = sw[1536 + 1024 + c], w22 = sw[3072 + 1024 + c], b2 = sb[1024 + c];
    const float hbias = p.in[I_HBIAS][l * 512 + c];
    const bf16* zT = (const bf16*)(ws + WS_ZHYT);
    f32x2* Kfg = (f32x2*)(ws + WS_H) + (size_t)blockIdx.x * 16384;
    float ssq = 0.f;
#pragma unroll 1
    for (int it = 0; it < 2; ++it) {
        if (it == 0) {
            const float* ff = filt + (size_t)c * SEQ; const float* fb = filt + (size_t)(512 + c) * SEQ;
#pragma unroll 4
            for (int j = 0; j < 8; ++j) { const int e0 = 4 * tid + 2048 * j; f32x4 v;
                if (e0 < SEQ) v = *(const f32x4*)(ff + e0);
                else { const int d0 = 16384 - e0; const f32x4 a = *(const f32x4*)(fb + d0 - 4); const float bq = d0 < SEQ ? fb[d0] : 0.f; v = (f32x4){bq, a[3], a[2], a[1]}; }
                ssq += (v[0] * v[0] + v[1] * v[1]) + (v[2] * v[2] + v[3] * v[3]);
                f32x2* xp = X + fidx(e0); *(f32x4*)xp = (f32x4){v[0], 0.f, v[1], 0.f}; *(f32x4*)(xp + 2) = (f32x4){v[2], 0.f, v[3], 0.f}; }
        } else {
#pragma unroll 1
            for (int j = 0; j < 2; ++j) { const int t0 = 8 * tid + 4096 * j; float u[2][8];
#pragma unroll
                for (int b = 0; b < 2; ++b) { const bf16* zb = zT + (size_t)(b * 1536 + c) * SEQ; float r1[10], r2[10]; ld10(zb + (size_t)512 * SEQ, t0, r1); ld10(zb + (size_t)1024 * SEQ, t0, r2);
#pragma unroll
                    for (int i = 0; i < 8; ++i) u[b][i] = (w10 * r1[i] + w11 * r1[i + 1] + w12 * r1[i + 2] + b1) * (w20 * r2[i] + w21 * r2[i + 1] + w22 * r2[i + 2] + b2); }
                f32x2* xp = X + fidx(t0); f32x2* xz = X + fidx(t0 + SEQ);
#pragma unroll
                for (int i = 0; i < 4; ++i) { *(f32x4*)(xp + 2 * i) = (f32x4){u[0][2 * i], u[1][2 * i], u[0][2 * i + 1], u[1][2 * i + 1]}; *(f32x4*)(xz + 2 * i) = (f32x4){0.f, 0.f, 0.f, 0.f}; } }
        }
        __syncthreads();
        fft_pass16<false, 10>(X, tid); __syncthreads();
        fft_pass16<false, 6>(X, tid); __syncthreads();
        fft_pass16<false, 2>(X, tid); __syncthreads();
        if (it == 0) {
#pragma unroll 4
            for (int j = 0; j < 8; ++j) { const int e0 = 4 * tid + 2048 * j; const f32x2* xp = X + fidx(e0);
                const f32x4 v01 = *(const f32x4*)xp, v23 = *(const f32x4*)(xp + 2);
                cf a0 = {v01[0], v01[1]}, a1 = {v01[2], v01[3]}, a2 = {v23[0], v23[1]}, a3 = {v23[2], v23[3]};
                dft4<false>(a0, a1, a2, a3);
                *(f32x4*)(Kfg + e0) = (f32x4){a0.x, a0.y, a1.x, a1.y}; *(f32x4*)(Kfg + e0 + 2) = (f32x4){a2.x, a2.y, a3.x, a3.y}; }
        } else {
#pragma unroll 4
            for (int j = 0; j < 8; ++j) { const int e0 = 4 * tid + 2048 * j; f32x2* xp = X + fidx(e0);
                const f32x4 k01 = *(const f32x4*)(Kfg + e0), k23 = *(const f32x4*)(Kfg + e0 + 2); const f32x4 v01 = *(const f32x4*)xp, v23 = *(const f32x4*)(xp + 2);
                cf a0 = {v01[0], v01[1]}, a1 = {v01[2], v01[3]}, a2 = {v23[0], v23[1]}, a3 = {v23[2], v23[3]};
                dft4<false>(a0, a1, a2, a3);
                a0 = cmul(a0, {k01[0], k01[1]}); a1 = cmul(a1, {k01[2], k01[3]}); a2 = cmul(a2, {k23[0], k23[1]}); a3 = cmul(a3, {k23[2], k23[3]});
                dft4<true>(a0, a1, a2, a3);
                *(f32x4*)xp = (f32x4){a0.x, a0.y, a1.x, a1.y}; *(f32x4*)(xp + 2) = (f32x4){a2.x, a2.y, a3.x, a3.y}; }
        }
        __syncthreads();
    }
    fft_pass16<true, 2>(X, tid); __syncthreads();
    fft_pass16<true, 6>(X, tid); __syncthreads();
    fft_pass16<true, 10>(X, tid); __syncthreads();
    const float tot = block_sum(ssq, red, lane, wid);
    const float scale = rsqrtf(tot) * (1.f / 16384.f);
    const bf16* gbT = (const bf16*)(ws + WS_GBT); bf16* gated = (bf16*)(ws + WS_GATED) + 512;
#pragma unroll 1
    for (int j = 0; j < 2; ++j) { const int t0 = 8 * tid + 4096 * j; const f32x2* xp = X + fidx(t0);
        float y[2][8];
#pragma unroll
        for (int i = 0; i < 4; ++i) { const f32x4 v = *(const f32x4*)(xp + 2 * i); y[0][2 * i] = v[0]; y[1][2 * i] = v[1]; y[0][2 * i + 1] = v[2]; y[1][2 * i + 1] = v[3]; }
#pragma unroll
        for (int b = 0; b < 2; ++b) { const bf16* zb = zT + (size_t)(b * 1536 + c) * SEQ; float r0[10], r1[10], r2[10]; ld10(zb, t0, r0); ld10(zb + (size_t)512 * SEQ, t0, r1); ld10(zb + (size_t)1024 * SEQ, t0, r2);
            const u32x4 graw = *(const u32x4*)(gbT + (size_t)(b * 512 + c) * SEQ + t0);
            float g[8]; g[0] = bf2f(graw.x & 0xffffu); g[1] = bf2f(graw.x >> 16); g[2] = bf2f(graw.y & 0xffffu); g[3] = bf2f(graw.y >> 16); g[4] = bf2f(graw.z & 0xffffu); g[5] = bf2f(graw.z >> 16); g[6] = bf2f(graw.w & 0xffffu); g[7] = bf2f(graw.w >> 16);
            bf16* gp = gated + ((size_t)b * SEQ + t0) * 1536 + c;
#pragma unroll
            for (int i = 0; i < 8; ++i) { const float x0 = w00 * r0[i] + w01 * r0[i + 1] + w02 * r0[i + 2] + b0; const float uu = (w10 * r1[i] + w11 * r1[i + 1] + w12 * r1[i + 2] + b1) * (w20 * r2[i] + w21 * r2[i + 1] + w22 * r2[i + 2] + b2);
                gp[(size_t)i * 1536] = f2bf(x0 * (y[b][i] * scale + hbias * uu) * g[i]); } } }
    __syncthreads();
}
__device__ __forceinline__ void hyena_ctx_pair(const Params& p, int l, int item0, unsigned char* lds, int wid0) {
    MK_TIDS(wid0)
    unsigned char* ws = p.ws;
    const int hsel = tid >> 8, t = tid & 255, item = item0 + hsel, b = item >> 9, c = item & 511;
    float* us = (float*)lds + hsel * 1024; float* kf = us + 256; float* kb = kf + 256; float* red = (float*)lds + 2048;
    const float* filt = (const float*)(ws + WS_FILTC) + (size_t)l * 262144;
    const float* sw = p.in[I_SW] + l * 3 * 1536; const float* sb = p.in[I_SB] + l * 1536;
    const bf16* z0 = (const bf16*)(ws + WS_ZHYTC) + (size_t)(b * 1536 + c) * CTXL;
    const float x0 = sconv(z0, t, CTXL, sw[c], sw[1536 + c], sw[3072 + c], sb[c]);
    const float x1 = sconv(z0 + 512 * CTXL, t, CTXL, sw[512 + c], sw[1536 + 512 + c], sw[3072 + 512 + c], sb[512 + c]);
    const float vv = sconv(z0 + 1024 * CTXL, t, CTXL, sw[1024 + c], sw[1536 + 1024 + c], sw[3072 + 1024 + c], sb[1024 + c]);
    const float uu = x1 * vv; const float fa = filt[(size_t)c * CTXL + t], fb = filt[(size_t)(512 + c) * CTXL + t];
    const float g = bf2f(((const bf16*)(ws + WS_GBTC))[(size_t)(b * 512 + c) * CTXL + t]); const float hb = p.in[I_HBIAS][l * 512 + c];
    us[t] = uu; kf[t] = fa; kb[t] = fb;
    const float ssq = wave_sum(fa * fa + (t >= 1 ? fb * fb : 0.f));
    if (lane == 0) red[wid] = ssq;
    __syncthreads();
    const float tot = (red[4 * hsel] + red[4 * hsel + 1]) + (red[4 * hsel + 2] + red[4 * hsel + 3]);
    float acc0 = 0.f, acc1 = 0.f;
#pragma unroll 8
    for (int s = 0; s < 256; s += 2) { acc0 += (s <= t ? kf[t - s] : kb[s - t]) * us[s]; acc1 += (s + 1 <= t ? kf[t - s - 1] : kb[s + 1 - t]) * us[s + 1]; }
    const float y = (acc0 + acc1) * rsqrtf(tot);
    bf16* gated = (bf16*)(ws + WS_GATED) + 512;
    gated[((size_t)MLAT + b * CTXL + t) * 1536 + c] = f2bf(x0 * (y + hb * uu) * g);
    __syncthreads();
}
__device__ __forceinline__ void gmlp_item(const Params& p, int l, int row0, int hf, unsigned char* lds, int wid0) {
    MK_TIDS(wid0)
    unsigned char* ws = p.ws;
    bf16* vT = (bf16*)lds;
    const bf16* zgm = (const bf16*)(ws + WS_ZGM); const bf16* gc = (const bf16*)(ws + WS_GC); bf16* gated = (bf16*)(ws + WS_GATED) + 1024;
    const float* lg = p.in[I_LNG] + l * 512 + 8 * lane; const float* lb = p.in[I_LNB] + l * 512 + 8 * lane;
    float g8[8], b8[8];
#pragma unroll
    for (int i = 0; i < 8; ++i) { g8[i] = lg[i]; b8[i] = lb[i]; }
#pragma unroll 1
    for (int hb = 0; hb < 2; ++hb) {
        u32x4 raw[8];
#pragma unroll
        for (int rr = 0; rr < 8; ++rr) raw[rr] = *(const u32x4*)(zgm + (size_t)(row0 + wid * 16 + hb * 8 + rr) * 1024 + 512 + 8 * lane);
        float v[8][8], s[8];
#pragma unroll
        for (int rr = 0; rr < 8; ++rr) { v[rr][0] = bf2f(raw[rr].x & 0xffffu); v[rr][1] = bf2f(raw[rr].x >> 16); v[rr][2] = bf2f(raw[rr].y & 0xffffu); v[rr][3] = bf2f(raw[rr].y >> 16); v[rr][4] = bf2f(raw[rr].z & 0xffffu); v[rr][5] = bf2f(raw[rr].z >> 16); v[rr][6] = bf2f(raw[rr].w & 0xffffu); v[rr][7] = bf2f(raw[rr].w >> 16);
            s[rr] = ((v[rr][0] + v[rr][1]) + (v[rr][2] + v[rr][3])) + ((v[rr][4] + v[rr][5]) + (v[rr][6] + v[rr][7])); }
#pragma unroll
        for (int rr = 0; rr < 8; ++rr) s[rr] = wave_sum(s[rr]) * (1.f / 512.f);
#pragma unroll
        for (int rr = 0; rr < 8; ++rr) { float q = 0.f;
#pragma unroll
            for (int i = 0; i < 8; ++i) { v[rr][i] -= s[rr]; q += v[rr][i] * v[rr][i]; }
            s[rr] = q; }
#pragma unroll
        for (int rr = 0; rr < 8; ++rr) s[rr] = rsqrtf(wave_sum(s[rr]) * (1.f / 512.f) + EPSN);
        if ((lane >> 5) == hf) {
#pragma unroll
            for (int rr = 0; rr < 8; ++rr) { const int q = wid * 16 + hb * 8 + rr;
#pragma unroll
                for (int i = 0; i < 8; ++i) vT[(8 * (lane & 31) + i) * 136 + q] = f2bf(v[rr][i] * s[rr] * g8[i] + b8[i]); } }
    }
    __syncthreads();
    const int r32 = lane & 31, hi = lane >> 5;
#pragma unroll 1
    for (int bi = 0; bi < 4; ++bi) { const int blk = wid + 8 * bi, gi = blk >> 3, pb = (blk >> 1) & 3, db = blk & 1; const int g = 4 * hf + gi;
        const float* wsrc = p.in[I_GWS] + ((size_t)(l * 8 + g) * 128 + 32 * pb + r32) * 128 + 8 * hi;
        const int ch = 256 * hf + 64 * gi + 32 * db + r32;
        float bsv[16]; bf16 uu[16], gg[16];
#pragma unroll
        for (int r = 0; r < 16; ++r) { const int pp = 32 * pb + crow(r, hi); const size_t row = (size_t)row0 + pp; bsv[r] = p.in[I_GBS][(l * 8 + g) * 128 + pp]; uu[r] = zgm[row * 1024 + ch]; gg[r] = gc[row * 512 + ch]; }
        f32x4 a0[8], a1[8];
#pragma unroll
        for (int ks = 0; ks < 8; ++ks) { a0[ks] = *(const f32x4*)(wsrc + 16 * ks); a1[ks] = *(const f32x4*)(wsrc + 16 * ks + 4); }
        f32x16 acc;
#pragma unroll
        for (int r = 0; r < 16; ++r) acc[r] = 0.f;
#pragma unroll
        for (int ks = 0; ks < 8; ++ks) {
            u32x4 aw; aw.x = pg8::cvt_pk_bf16(a0[ks][0], a0[ks][1]); aw.y = pg8::cvt_pk_bf16(a0[ks][2], a0[ks][3]); aw.z = pg8::cvt_pk_bf16(a1[ks][0], a1[ks][1]); aw.w = pg8::cvt_pk_bf16(a1[ks][2], a1[ks][3]);
            const bf16x8 bfr = *(const bf16x8*)(vT + (64 * gi + 32 * db + r32) * 136 + 16 * ks + 8 * hi);
            acc = __builtin_amdgcn_mfma_f32_32x32x16_bf16(__builtin_bit_cast(bf16x8, aw), bfr, acc, 0, 0, 0); }
#pragma unroll
        for (int r = 0; r < 16; ++r) { const int pp = 32 * pb + crow(r, hi); const size_t row = (size_t)row0 + pp;
            gated[row * 1536 + ch] = f2bf(bf2f(uu[r]) * (acc[r] + bsv[r]) * bf2f(gg[r])); } }
    __syncthreads();
}
template <bool MERGE> __device__ __forceinline__ void ctx_mini_gemm(const Params& p, unsigned char* lds, int wid0) {
    MK_TIDS(wid0)
    unsigned char* ws = p.ws;
    const int r32 = lane & 31, hi = lane >> 5;
    float* part = (float*)lds;
    for (int tile = blockIdx.x; tile < 256; tile += gridDim.x) {
        const int rb = tile >> 4, cb = tile & 15; const size_t arow = (size_t)MLAT + 32 * rb + r32;
        f32x16 tot[2];
#pragma unroll
        for (int c2 = 0; c2 < 2; ++c2)
#pragma unroll
            for (int r = 0; r < 16; ++r) tot[c2][r] = 0.f;
        if (MERGE) {
            const bf16* A = (const bf16*)(ws + WS_GATED) + arow * 1536 + 64 * wid + 8 * hi; const bf16* B = (const bf16*)(ws + WS_WBR) + (size_t)(64 * cb + r32) * 1536 + 64 * wid + 8 * hi;
            const bf16* sel = (const bf16*)(ws + WS_SEL);
#pragma unroll
            for (int i = 0; i < 3; ++i) { f32x16 acc[2];
#pragma unroll
                for (int c2 = 0; c2 < 2; ++c2)
#pragma unroll
                    for (int r = 0; r < 16; ++r) acc[c2][r] = 0.f;
#pragma unroll
                for (int ks = 0; ks < 4; ++ks) { const bf16x8 a = *(const bf16x8*)(A + i * 512 + 16 * ks), b0 = *(const bf16x8*)(B + i * 512 + 16 * ks), b1 = *(const bf16x8*)(B + (size_t)32 * 1536 + i * 512 + 16 * ks);
                    acc[0] = __builtin_amdgcn_mfma_f32_32x32x16_bf16(a, b0, acc[0], 0, 0, 0); acc[1] = __builtin_amdgcn_mfma_f32_32x32x16_bf16(a, b1, acc[1], 0, 0, 0); }
#pragma unroll
                for (int c2 = 0; c2 < 2; ++c2)
#pragma unroll
                    for (int r = 0; r < 16; ++r) tot[c2][r] += acc[c2][r] * bf2f(sel[((size_t)MLAT + 32 * rb + crow(r, hi)) * 3072 + i * 1024 + 64 * cb + 32 * c2 + r32]); }
        } else {
            const bf16* A = (const bf16*)(ws + WS_OUTPRE) + arow * 1024 + 128 * wid + 8 * hi; const bf16* B = (const bf16*)(ws + WS_WOUT) + (size_t)(64 * cb + r32) * 1024 + 128 * wid + 8 * hi;
#pragma unroll
            for (int ks = 0; ks < 8; ++ks) { const bf16x8 a = *(const bf16x8*)(A + 16 * ks), b0 = *(const bf16x8*)(B + 16 * ks), b1 = *(const bf16x8*)(B + (size_t)32 * 1024 + 16 * ks);
                tot[0] = __builtin_amdgcn_mfma_f32_32x32x16_bf16(a, b0, tot[0], 0, 0, 0); tot[1] = __builtin_amdgcn_mfma_f32_32x32x16_bf16(a, b1, tot[1], 0, 0, 0); }
        }
#pragma unroll
        for (int c2 = 0; c2 < 2; ++c2)
#pragma unroll
            for (int r = 0; r < 16; ++r) part[(wid * 32 + crow(r, hi)) * 64 + 32 * c2 + r32] = tot[c2][r];
        __syncthreads();
        { const int e = 4 * tid, rr = e >> 6, cc = e & 63; f32x4 sum = *(const f32x4*)(part + e);
#pragma unroll
          for (int w = 1; w < 8; ++w) sum = sum + *(const f32x4*)(part + w * 2048 + e);
          const size_t row = (size_t)MLAT + 32 * rb + rr; const int col = 64 * cb + cc;
          if (MERGE) { u32x2 o; o.x = pg8::cvt_pk_bf16(sum[0], sum[1]); o.y = pg8::cvt_pk_bf16(sum[2], sum[3]); *(u32x2*)((bf16*)(ws + WS_OUTPRE) + row * 1024 + col) = o; }
          else { u32x2 o; o.x = pg8::cvt_pk_bf16(sum[0], sum[1]); o.y = pg8::cvt_pk_bf16(sum[2], sum[3]); *(u32x2*)((bf16*)(ws + WS_OUT) + row * 1024 + col) = o; } }
        __syncthreads();
    }
}
#define XB_TMO      128
#define XB_XCNT(j)  (256  + 64 * (j))
#define XB_XSUB(j)  (1280 + 64 * (j))
#define XB_XGEN(j)  (2304 + 64 * (j))
#define XB_TOP      3328
#define XB_TOPGEN   3392
#define XCD_BAR_WORDS 3456
#define XB_SPIN_CAP (1u << 18)

__device__ __forceinline__ unsigned xb_ld(unsigned* p)              { return __hip_atomic_load(p, __ATOMIC_RELAXED, __HIP_MEMORY_SCOPE_AGENT); }
__device__ __forceinline__ unsigned xb_add(unsigned* p, unsigned v) { return __hip_atomic_fetch_add(p, v, __ATOMIC_RELAXED, __HIP_MEMORY_SCOPE_AGENT); }
__device__ __forceinline__ unsigned xb_xcc_id() { return (unsigned)__builtin_amdgcn_s_getreg((3 << 11) | 20) & 0xFu; }
#define XB_SPIN(cond, bar) do { unsigned _sp = 0; while (cond) { __builtin_amdgcn_s_sleep(1); \
    if ((++_sp & 255u) == 0u) { if (xb_ld(&(bar)[XB_TMO])) break; if (_sp > XB_SPIN_CAP) { atomicAdd(&(bar)[XB_TMO], 1u); break; } } } } while (0)

struct XcdBarrier {
    unsigned* bar; unsigned x;
    volatile LAS unsigned* st;
};

__device__ __forceinline__ XcdBarrier xcd_barrier_post(unsigned* bar, volatile LAS unsigned* st) {
    XcdBarrier b; b.bar = bar; b.x = xb_xcc_id(); b.st = st;
    if (threadIdx.x == 0) (void)xb_add(&bar[XB_XCNT(b.x)], 1u);
    return b;
}
__device__ __forceinline__ void xcd_barrier_complete(unsigned* bar, unsigned x, unsigned& nloc, unsigned& nx) {
    const unsigned G = gridDim.x * gridDim.y * gridDim.z;
    unsigned sum, cnt, mine, sp = 0u;
    for (;;) {
        sum = 0u; cnt = 0u; mine = 0u;
#pragma unroll
        for (unsigned j = 0; j < 16; ++j) { const unsigned c = xb_ld(&bar[XB_XCNT(j)]); sum += c; cnt += (c > 0u) ? 1u : 0u; mine = (j == x) ? c : mine; }
        if (sum == G) break;
        __builtin_amdgcn_s_sleep(1);
        if ((++sp & 255u) == 0u) { if (xb_ld(&bar[XB_TMO])) break; if (sp > XB_SPIN_CAP) { atomicAdd(&bar[XB_TMO], 1u); break; } }
    }
    nloc = mine > 0u ? mine : 1u; nx = cnt > 0u ? cnt : 1u;
}

__device__ __forceinline__ void xcd_barrier(const XcdBarrier& b) {
    asm volatile("s_waitcnt vmcnt(0)" ::: "memory");
    __syncthreads();
    if (threadIdx.x == 0) {
        unsigned* bar = b.bar;
        __builtin_amdgcn_s_waitcnt(0);
        unsigned nloc = b.st[0], nx = b.st[1];
        if (nloc == 0u) { xcd_barrier_complete(bar, b.x, nloc, nx); b.st[0] = nloc; b.st[1] = nx; }
        const unsigned old = xb_add(&bar[XB_XSUB(b.x)], 1u);
        const unsigned gen = old / nloc;
        if (old + 1u == (gen + 1u) * nloc) {
            __builtin_amdgcn_fence(__ATOMIC_RELEASE, "agent");
            asm volatile("s_waitcnt vmcnt(0)" ::: "memory");
            const unsigned og = xb_add(&bar[XB_TOP], 1u);
            const unsigned tg = og / nx;
            if (og + 1u == (tg + 1u) * nx) xb_add(&bar[XB_TOPGEN], 1u);
            else XB_SPIN(xb_ld(&bar[XB_TOPGEN]) == tg, bar);
            __builtin_amdgcn_fence(__ATOMIC_ACQUIRE, "agent");
            xb_add(&bar[XB_XGEN(b.x)], 1u);
            asm volatile("s_waitcnt vmcnt(0)" ::: "memory");
        } else {
            XB_SPIN(xb_ld(&bar[XB_XGEN(b.x)]) == gen, bar);
            __builtin_amdgcn_fence(__ATOMIC_ACQUIRE, "agent");
            asm volatile("s_waitcnt vmcnt(0)" ::: "memory");
        }
    }
    __syncthreads();
}

__device__ __forceinline__ void phaseC(const Params& p, int l, unsigned char* lds, int wid0) {
    int lane; asm volatile("v_mbcnt_lo_u32_b32 %0, -1, 0\n\tv_mbcnt_hi_u32_b32 %0, -1, %0" : "=v"(lane));
    const bool last = (l == DEPTH - 1);
    const float lam_init = 0.8f - 0.6f * expf(-0.3f * (float)l);
    float lam;
    { const float* lp = p.in[I_LAM] + l * 256; const float s1 = wave_sum(lp[lane] * lp[64 + lane]), s2 = wave_sum(lp[128 + lane] * lp[192 + lane]); lam = expf(s1) - expf(s2) + lam_init; }
    const int G = gridDim.x, bx = blockIdx.x;
    const bool att_first = (G == 0);
    for (int pass = 0; pass < 2; ++pass) {
    if ((pass == 0) == att_first) {
#ifndef NO_ATT
    for (int rep = 0; rep < REP_ATT; ++rep)
    { const int nun = last ? 64 : 66;
      const int xg = (G % 8 == 0) ? 8 : 1, xi = bx % xg, ji = bx / xg, jn = G / xg;
      for (int bh = xi; bh < 8; bh += xg)
        for (int qb = ji; qb < nun; qb += jn) {
            const int b = bh >> 2, h = bh & 3; int qpos0, kbeg, nkt, grow0;
            if (qb < 64) { qpos0 = qb * 128; kbeg = 0; nkt = KEYS / 64; grow0 = b * SEQ + qb * 128; }
            else { qpos0 = SEQ + (qb - 64) * 128; kbeg = SEQ; nkt = CTXL / 64; grow0 = MLAT + b * CTXL + (qb - 64) * 128; }
            attn_unit(p, l, b, h, qpos0, kbeg, nkt, grow0, lam, lam_init, lds, wid0); } }
#endif
    } else {
#ifndef NO_HY
    for (int rep = 0; rep < REP_HY; ++rep)
    for (int k = bx; k < 512; k += G) { const int c = (G == 256) ? (64 * (k & 7) + 32 * (k >> 8) + ((k & 255) >> 3)) : k;     hyena_channel(p, l, c, lds, wid0); }
#endif
#ifndef NO_HYC
    if (!last) for (int k = bx; k < 512; k += G) { const int it = (G == 256) ? ((k & 256) + 32 * (k & 7) + (((k & 255) >> 3) & 15) + 16 * ((k & 255) >> 7)) : k; hyena_ctx_pair(p, l, 2 * it, lds, wid0); }
#endif
#ifndef NO_GM
    for (int rep = 0; rep < REP_GM; ++rep)
    for (int it = bx; it < 256; it += G) gmlp_item(p, l, (it >> 1) * 128, it & 1, lds, wid0);
    if (!last) for (int it = (bx >= 128 ? bx - 128 : bx + G - 128); it < 8; it += G) gmlp_item(p, l, MLAT + (it >> 1) * 128, it & 1, lds, wid0);
#endif
    }
    }
}
__device__ __forceinline__ void phaseB(const Params& p, int l, unsigned char* lds, int wid0) {
    unsigned char* ws = p.ws;
    pg8::Gemm g{(const bf16*)(ws + WS_H), (const bf16*)(ws + WS_WIN), MROWS, NCOL, 1024}; pg8::StaticOrder S; S.init(MROWS, NCOL, gridDim.x, blockIdx.x);
    EpiIn E; E.K = (bf16*)(ws + WS_K); E.Q = (bf16*)(ws + WS_Q); E.Vt = (bf16*)(ws + WS_VT); E.ga = (bf16*)(ws + WS_GA); E.gc = (bf16*)(ws + WS_GC); E.zgm = (bf16*)(ws + WS_ZGM); E.sel = (bf16*)(ws + WS_SEL);
    E.zhyT = (bf16*)(ws + WS_ZHYT); E.zhyTc = (bf16*)(ws + WS_ZHYTC); E.gbT = (bf16*)(ws + WS_GBT); E.gbTc = (bf16*)(ws + WS_GBTC); E.rope = (const float*)(ws + WS_ROPE); E.kmax = (unsigned*)(ws + WS_CTL) + l * 32; E.last = (l == DEPTH - 1);
    pg8::gemm_phase<EpiIn, pg8::StaticOrder, true, true>((PG8_LAS unsigned char*)lds, g, S, E, mk_tid(wid0));
}
__device__ __forceinline__ void phaseD(const Params& p, int l, unsigned char* lds, int wid0) {
    unsigned char* ws = p.ws; const int M = MLAT;
    pg8::StaticOrder S; S.init(M, 1024, gridDim.x, blockIdx.x);
    pg8::Gemm g{(const bf16*)(ws + WS_GATED), (const bf16*)(ws + WS_WBR), M, 1024, 1536};
    EpiMergeF E{(const bf16*)(ws + WS_SEL), (bf16*)(ws + WS_OUTPRE)}; MergeHook H{(const bf16*)(ws + WS_SEL)};
    pg8::gemm_phase<EpiMergeF, pg8::StaticOrder, true, true, MergeHook>((PG8_LAS unsigned char*)lds, g, S, E, mk_tid(wid0), H);
    if (l < DEPTH - 1) { __syncthreads(); ctx_mini_gemm<true>(p, lds, wid0); }
}
__device__ __forceinline__ void phaseE(const Params& p, int l, unsigned char* lds, int wid0) {
    unsigned char* ws = p.ws;
    const int M = MLAT;
    pg8::Gemm g{(const bf16*)(ws + WS_OUTPRE), (const bf16*)(ws + WS_WOUT), M, 1024, 1024}; pg8::StaticOrder S; S.init(M, 1024, gridDim.x, blockIdx.x);
    EpiOut E{(bf16*)(ws + WS_OUT), (l == DEPTH - 1)};
    pg8::gemm_phase<EpiOut, pg8::StaticOrder, true, true>((PG8_LAS unsigned char*)lds, g, S, E, mk_tid(wid0));
    if (l < DEPTH - 1) { __syncthreads(); ctx_mini_gemm<false>(p, lds, wid0); }
}

__global__ void __launch_bounds__(512, 2) mk_fwd(Params p) {
    extern __shared__ __attribute__((aligned(16))) unsigned char lds[];
    const int wid0 = __builtin_amdgcn_readfirstlane(threadIdx.x >> 6);
    volatile LAS unsigned* bst = (volatile LAS unsigned*)((LAS unsigned char*)lds + LDS_BYTES - 64);
    if (threadIdx.x < 2) bst[threadIdx.x] = 0u;
    __syncthreads();
    XcdBarrier bar; bar.bar = (unsigned*)(p.ws + WS_BAR); bar.x = 0; bar.st = bst;
    if (p.ph_hi - p.ph_lo > 1) bar = xcd_barrier_post((unsigned*)(p.ws + WS_BAR), bst);
    for (int ph = p.ph_lo; ph < p.ph_hi; ++ph) {
        if (ph == p.ph_lo + 1) cg::this_grid().sync();
        else if (ph > p.ph_lo) for (int rep = 0; rep < REP_SYNC; ++rep) xcd_barrier(bar);
#ifndef NO_0
        if (ph == 0) { phase0(p, wid0); __syncthreads();
            for (int it = blockIdx.x; it < 24; it += gridDim.x) filter_item(p, it >> 3, CTXL, 32 * (it & 7), (float*)(p.ws + WS_FILTC) + (size_t)(it >> 3) * 262144, (float*)(lds + 104448), wid0);
            continue; }
#endif
#ifndef NO_A
        if (ph == NPHASE - 1) { phaseA(p, DEPTH, lds, wid0); continue; }
#endif
        const int l = (ph - 1) / 5, s = (ph - 1) % 5;
#ifndef NO_A
        if (s == 0) phaseA(p, l, lds, wid0);
#endif
#ifndef NO_B
        if (s == 1) for (int rep = 0; rep < REP_B; ++rep) phaseB(p, l, lds, wid0);
#endif
#ifndef NO_C
        if (s == 2) phaseC(p, l, lds, wid0);
#endif
#ifndef NO_D
        if (s == 3) for (int rep = 0; rep < REP_DE; ++rep) phaseD(p, l, lds, wid0);
#endif
#ifndef NO_E
        if (s == 4) for (int rep = 0; rep < REP_DE; ++rep) phaseE(p, l, lds, wid0);
#endif
        __syncthreads();
    }
}

extern "C" void kernel_launch(void* const* d_in, const int* in_sizes, int n_in, void* d_out, int out_size, void* d_ws, size_t ws_size, hipStream_t stream) {
    static int grid = 0;
    if (grid == 0) {
        if (n_in != 26 || out_size != MLAT * DM || ws_size < WS_END) { fprintf(stderr, "kernel_launch: unexpected shapes / workspace (n_in %d out %d ws %zu)\n", n_in, out_size, ws_size); grid = -1; }
        else {
            int dev = 0, cus = 0, per_cu = 0;
            hipGetDevice(&dev); hipDeviceGetAttribute(&cus, hipDeviceAttributeMultiprocessorCount, dev);
            hipFuncSetAttribute((const void*)mk_fwd, hipFuncAttributeMaxDynamicSharedMemorySize, LDS_BYTES);
            hipOccupancyMaxActiveBlocksPerMultiprocessor(&per_cu, (const void*)mk_fwd, 512, LDS_BYTES);
            (void)hipGetLastError();
            if (per_cu < 1) per_cu = 1;
            grid = cus;
        }
    }
    if (grid < 0) { hipMemsetAsync(d_out, 0, (size_t)out_size * 4, stream); return; }
    hipMemsetAsync((char*)d_ws + WS_BAR, 0, XCD_BAR_WORDS * 4, stream);
    Params p{};
    for (int i = 0; i < 26; ++i) p.in[i] = (const float*)d_in[i];
    p.out = (float*)d_out; p.ws = (unsigned char*)d_ws;
#if MK_ONE_LAUNCH
    p.ph_lo = 0; p.ph_hi = NPHASE;
    void* args[] = {&p};
    hipError_t e = hipLaunchCooperativeKernel((const void*)mk_fwd, dim3(grid), dim3(512), args, LDS_BYTES, stream);
    if (e != hipSuccess) fprintf(stderr, "cooperative launch failed: %s (grid %d)\n", hipGetErrorString(e), grid);
#else
    for (int ph = 0; ph < NPHASE; ++ph) { p.ph_lo = ph; p.ph_hi = ph + 1; hipLaunchKernelGGL(mk_fwd, dim3(grid), dim3(512), LDS_BYTES, stream, p); }
#endif
}
```
